# Optimizing an MI355X kernel written in HIP

```python
import math
import jax, jax.numpy as jnp
from jax import lax
import numpy as np

D_MODEL = 4096
BATCH = 4
SEQ = 2048
DEPTH = 2
DEC_BATCH = 16
DEC_SEQ = 32
PAST_LEN = 1024

CHUNK = 64
N_EVEN = (DEPTH + 1) // 2
N_ODD = DEPTH // 2
EPS = 1e-6
HEAD_DIM_AB = 128
N_HEADS_SB = D_MODEL // (2 * HEAD_DIM_AB)
N_HEADS_BAND = D_MODEL // (2 * HEAD_DIM_AB)
W_SB = N_HEADS_SB * HEAD_DIM_AB
W_BAND = N_HEADS_BAND * HEAD_DIM_AB
SB_BLOCK = 128
BAND_PREV_CHUNKS = 8
BAND_HIST = BAND_PREV_CHUNKS * CHUNK
REL_CLIP = 2 * CHUNK
HEAD_DIM_C = 64
N_HEADS_C = D_MODEL // HEAD_DIM_C
N_KV_C = 8
WINDOW = 128
SWA_PREV_CHUNKS = WINDOW // CHUNK
ROPE_THETA = 500000.0
ROPE_DIM = HEAD_DIM_C // 4
D_FF = ((8 * D_MODEL // 3 + 255) // 256) * 256

kernel_name = "stickbreak_band_swa_stream_step"


def _rmsnorm(x, g):
    x32 = x.astype(jnp.float32)
    y = x32 * lax.rsqrt(jnp.mean(x32 * x32, axis=-1, keepdims=True) + EPS)
    return (y * g.astype(jnp.float32)).astype(x.dtype)


def _swiglu(x, wg, wu, wd):
    return (jax.nn.silu(x @ wg) * (x @ wu)) @ wd


def _rope_partial(x, pos):
    half = ROPE_DIM // 2
    inv = jnp.power(ROPE_THETA, -jnp.arange(half, dtype=jnp.float32) / half)
    ang = pos.astype(jnp.float32)[:, None] * inv[None, :]
    cos = jnp.cos(ang)[None, :, None, :]
    sin = jnp.sin(ang)[None, :, None, :]
    x1 = x[..., :half].astype(jnp.float32)
    x2 = x[..., half:ROPE_DIM].astype(jnp.float32)
    rot = jnp.concatenate([x1 * cos - x2 * sin, x2 * cos + x1 * sin], axis=-1).astype(x.dtype)
    return jnp.concatenate([rot, x[..., ROPE_DIM:]], axis=-1)


def _band_mask(q_pos, k_pos, n_prev):
    qc = q_pos[:, None] // CHUNK
    kc = k_pos[None, :] // CHUNK
    return (k_pos[None, :] >= 0) & (kc <= qc) & (kc >= qc - n_prev)


def _band_logit_bias(q_pos, k_pos, n_prev, rel_table):
    mask = _band_mask(q_pos, k_pos, n_prev)
    if rel_table is None:
        b = jnp.zeros((1,) + mask.shape, jnp.float32)
    else:
        d = jnp.clip(q_pos[:, None] - k_pos[None, :], -REL_CLIP, REL_CLIP) + REL_CLIP
        b = rel_table.astype(jnp.float32)[:, d]
    return jnp.where(mask[None], b, -jnp.inf)


def _softmax_attn(q, k, v, bias, sinks):
    B, Tq, Hq, D = q.shape
    Tk, Hkv = k.shape[1], k.shape[2]
    G = Hq // Hkv
    qg = q.reshape(B, Tq, Hkv, G, D)
    s = jnp.einsum('bqhgd,bkhd->bhgqk', qg, k).astype(jnp.float32) * (D ** -0.5)
    s = s + jnp.broadcast_to(bias, (Hq, Tq, Tk)).reshape(Hkv, G, Tq, Tk)
    if sinks is None:
        p = jax.nn.softmax(s, axis=-1)
    else:
        sk = jnp.broadcast_to(sinks.astype(jnp.float32).reshape(Hkv, G, 1, 1), s.shape[:-1] + (1,))
        p = jax.nn.softmax(jnp.concatenate([s, sk], axis=-1), axis=-1)[..., :-1]
    o = jnp.einsum('bhgqk,bkhd->bqhgd', p.astype(v.dtype), v)
    return o.reshape(B, Tq, Hq, D)


def _band_attn_prompt(q, k, v, n_prev, rel_table, sinks):
    B, S, Hq, D = q.shape
    nc = S // CHUNK
    hist = n_prev * CHUNK
    band = hist + CHUNK
    pad = ((0, 0), (hist, 0), (0, 0), (0, 0))
    kp = jnp.pad(k, pad)
    vp = jnp.pad(v, pad)
    qc = jnp.moveaxis(q.reshape(B, nc, CHUNK, Hq, D), 1, 0)

    def one(args):
        c, q_blk = args
        start = c * CHUNK
        kb = lax.dynamic_slice_in_dim(kp, start, band, axis=1)
        vb = lax.dynamic_slice_in_dim(vp, start, band, axis=1)
        q_pos = start + jnp.arange(CHUNK)
        k_pos = start - hist + jnp.arange(band)
        return _softmax_attn(q_blk, kb, vb, _band_logit_bias(q_pos, k_pos, n_prev, rel_table), sinks)

    out = lax.map(one, (jnp.arange(nc), qc))
    return jnp.moveaxis(out, 0, 1).reshape(B, S, Hq, D)


def _band_attn_step(q, k_new, v_new, k_cache, v_cache, n_prev, rel_table, sinks):
    P = k_cache.shape[1]
    T = q.shape[1]
    k = jnp.concatenate([k_cache, k_new], axis=1)
    v = jnp.concatenate([v_cache, v_new], axis=1)
    q_pos = PAST_LEN + jnp.arange(T)
    k_pos = PAST_LEN - P + jnp.arange(P + T)
    o = _softmax_attn(q, k, v, _band_logit_bias(q_pos, k_pos, n_prev, rel_table), sinks)
    return o, k[:, -P:], v[:, -P:]


def _stick_breaking(q, k, v, q_pos, k_pos):
    D = q.shape[-1]
    z = jnp.einsum('bqhd,bkhd->bhqk', q, k).astype(jnp.float32) * (D ** -0.5)
    valid = k_pos[None, :] < q_pos[:, None]
    log_beta = jax.nn.log_sigmoid(z)
    log_1m = jnp.where(valid, jax.nn.log_sigmoid(-z), 0.0)
    after = lax.cumsum(log_1m, axis=3, reverse=True) - log_1m
    w = jnp.where(valid, jnp.exp(log_beta + after), 0.0)
    return jnp.einsum('bhqk,bkhd->bqhd', w.astype(v.dtype), v)


def _stick_breaking_prompt(q, k, v):
    B, S, H, D = q.shape
    nb = S // SB_BLOCK
    qb = jnp.moveaxis(q.reshape(B, nb, SB_BLOCK, H, D), 1, 0)
    k_pos = jnp.arange(S)

    def one(args):
        i, q_blk = args
        q_pos = i * SB_BLOCK + jnp.arange(SB_BLOCK)
        return _stick_breaking(q_blk, k, v, q_pos, k_pos)

    out = lax.map(one, (jnp.arange(nb), qb))
    return jnp.moveaxis(out, 0, 1).reshape(B, S, H, D)


def _split_ab(hn, w_in):
    B, T, _ = hn.shape
    proj = hn @ w_in
    idx = [W_SB, 2 * W_SB, 3 * W_SB, 3 * W_SB + W_BAND, 3 * W_SB + 2 * W_BAND]
    qa, ka, va, qb, kb, vb = jnp.split(proj, idx, axis=-1)
    ra = lambda t: t.reshape(B, T, N_HEADS_SB, HEAD_DIM_AB)
    rb = lambda t: t.reshape(B, T, N_HEADS_BAND, HEAD_DIM_AB)
    return ra(qa), ra(ka), ra(va), rb(qb), rb(kb), rb(vb)


def _split_c(hn, w_qkv, pos):
    B, T, _ = hn.shape
    proj = hn @ w_qkv
    wq = N_HEADS_C * HEAD_DIM_C
    wk = N_KV_C * HEAD_DIM_C
    q, k, v = jnp.split(proj, [wq, wq + wk], axis=-1)
    q = _rope_partial(q.reshape(B, T, N_HEADS_C, HEAD_DIM_C), pos)
    k = _rope_partial(k.reshape(B, T, N_KV_C, HEAD_DIM_C), pos)
    return q, k, v.reshape(B, T, N_KV_C, HEAD_DIM_C)


def setup_inputs(seed: int = 0) -> dict:
    key = jax.random.key(seed)
    ks = jax.random.split(key, 24)
    f32 = jnp.float32

    def nrm(k, shape, scale):
        return jax.random.normal(k, shape, f32) * scale

    p_band = min(BAND_HIST, PAST_LEN)
    p_swa = min(WINDOW, PAST_LEN)
    in_ab = 3 * W_SB + 3 * W_BAND
    qkv_c = (N_HEADS_C + 2 * N_KV_C) * HEAD_DIM_C
    return {
        "x_prompt": nrm(ks[0], (BATCH, SEQ, D_MODEL), 1.0),
        "x_sample": nrm(ks[1], (DEC_BATCH, DEC_SEQ, D_MODEL), 1.0),
        "cache_sb_k": nrm(ks[2], (N_EVEN, DEC_BATCH, PAST_LEN, N_HEADS_SB, HEAD_DIM_AB), 1.0),
        "cache_sb_v": nrm(ks[3], (N_EVEN, DEC_BATCH, PAST_LEN, N_HEADS_SB, HEAD_DIM_AB), 1.0),
        "cache_band_k": nrm(ks[4], (N_EVEN, DEC_BATCH, p_band, N_HEADS_BAND, HEAD_DIM_AB), 1.0),
        "cache_band_v": nrm(ks[5], (N_EVEN, DEC_BATCH, p_band, N_HEADS_BAND, HEAD_DIM_AB), 1.0),
        "cache_swa_k": nrm(ks[6], (N_ODD, DEC_BATCH, p_swa, N_KV_C, HEAD_DIM_C), 1.0),
        "cache_swa_v": nrm(ks[7], (N_ODD, DEC_BATCH, p_swa, N_KV_C, HEAD_DIM_C), 1.0),
        "norm_mix": 1.0 + nrm(ks[8], (DEPTH, D_MODEL), 0.02),
        "norm_ffn": 1.0 + nrm(ks[9], (DEPTH, D_MODEL), 0.02),
        "norm_final": 1.0 + nrm(ks[10], (D_MODEL,), 0.02),
        "w_in_ab": nrm(ks[11], (N_EVEN, D_MODEL, in_ab), D_MODEL ** -0.5),
        "w_out_ab": nrm(ks[12], (N_EVEN, W_SB + W_BAND, D_MODEL), (W_SB + W_BAND) ** -0.5),
        "rel_bias": nrm(ks[13], (N_EVEN, N_HEADS_BAND, 2 * REL_CLIP + 1), 0.1),
        "w_qkv_c": nrm(ks[14], (N_ODD, D_MODEL, qkv_c), D_MODEL ** -0.5),
        "w_out_c": nrm(ks[15], (N_ODD, N_HEADS_C * HEAD_DIM_C, D_MODEL), (N_HEADS_C * HEAD_DIM_C) ** -0.5),
        "sinks": nrm(ks[16], (N_ODD, N_HEADS_C), 1.0),
        "w_gate": nrm(ks[17], (DEPTH, D_MODEL, D_FF), D_MODEL ** -0.5),
        "w_up": nrm(ks[18], (DEPTH, D_MODEL, D_FF), D_MODEL ** -0.5),
        "w_down": nrm(ks[19], (DEPTH, D_FF, D_MODEL), D_FF ** -0.5),
    }


def reference(x_prompt, x_sample, cache_sb_k, cache_sb_v, cache_band_k, cache_band_v,
              cache_swa_k, cache_swa_v, norm_mix, norm_ffn, norm_final, w_in_ab, w_out_ab,
              rel_bias, w_qkv_c, w_out_c, sinks, w_gate, w_up, w_down):
    hp, hs = x_prompt, x_sample
    Bp, S, _ = hp.shape
    Bs, T, _ = hs.shape
    pos_p = jnp.arange(S)
    pos_s = PAST_LEN + jnp.arange(T)
    k_pos_sb = jnp.arange(PAST_LEN + T)

    sbk_p, sbv_p, bk_p, bv_p, ck_p, cv_p = [], [], [], [], [], []
    sbk_s, sbv_s, bk_s, bv_s, ck_s, cv_s = [], [], [], [], [], []

    for l in range(DEPTH):
        hn_p = _rmsnorm(hp, norm_mix[l])
        hn_s = _rmsnorm(hs, norm_mix[l])
        if l % 2 == 0:
            e = l // 2
            qa, ka, va, qb, kb, vb = _split_ab(hn_p, w_in_ab[e])
            oa = _stick_breaking_prompt(qa, ka, va)
            ob = _band_attn_prompt(qb, kb, vb, BAND_PREV_CHUNKS, rel_bias[e], None)
            hp = hp + jnp.concatenate([oa.reshape(Bp, S, W_SB), ob.reshape(Bp, S, W_BAND)], axis=-1) @ w_out_ab[e]
            nb = min(BAND_HIST, S)
            sbk_p.append(ka)
            sbv_p.append(va)
            bk_p.append(kb[:, S - nb:])
            bv_p.append(vb[:, S - nb:])
            qa, ka, va, qb, kb, vb = _split_ab(hn_s, w_in_ab[e])
            k_all = jnp.concatenate([cache_sb_k[e], ka], axis=1)
            v_all = jnp.concatenate([cache_sb_v[e], va], axis=1)
            oa = _stick_breaking(qa, k_all, v_all, pos_s, k_pos_sb)
            ob, nbk, nbv = _band_attn_step(qb, kb, vb, cache_band_k[e], cache_band_v[e],
                                           BAND_PREV_CHUNKS, rel_bias[e], None)
            hs = hs + jnp.concatenate([oa.reshape(Bs, T, W_SB), ob.reshape(Bs, T, W_BAND)], axis=-1) @ w_out_ab[e]
            sbk_s.append(ka)
            sbv_s.append(va)
            bk_s.append(nbk)
            bv_s.append(nbv)
        else:
            o = l // 2
            q, k, v = _split_c(hn_p, w_qkv_c[o], pos_p)
            oc = _band_attn_prompt(q, k, v, SWA_PREV_CHUNKS, None, sinks[o])
            hp = hp + oc.reshape(Bp, S, N_HEADS_C * HEAD_DIM_C) @ w_out_c[o]
            nw = min(WINDOW, S)
            ck_p.append(k[:, S - nw:])
            cv_p.append(v[:, S - nw:])
            q, k, v = _split_c(hn_s, w_qkv_c[o], pos_s)
            oc, nck, ncv = _band_attn_step(q, k, v, cache_swa_k[o], cache_swa_v[o],
                                           SWA_PREV_CHUNKS, None, sinks[o])
            hs = hs + oc.reshape(Bs, T, N_HEADS_C * HEAD_DIM_C) @ w_out_c[o]
            ck_s.append(nck)
            cv_s.append(ncv)
        hp = hp + _swiglu(_rmsnorm(hp, norm_ffn[l]), w_gate[l], w_up[l], w_down[l])
        hs = hs + _swiglu(_rmsnorm(hs, norm_ffn[l]), w_gate[l], w_up[l], w_down[l])

    y_prompt = _rmsnorm(hp, norm_final)
    y_sample = _rmsnorm(hs, norm_final)
    return (y_prompt, y_sample,
            jnp.stack(sbk_p), jnp.stack(sbv_p), jnp.stack(bk_p), jnp.stack(bv_p),
            jnp.stack(ck_p), jnp.stack(cv_p),
            jnp.stack(sbk_s), jnp.stack(sbv_s), jnp.stack(bk_s), jnp.stack(bv_s),
            jnp.stack(ck_s), jnp.stack(cv_s))
```

```cpp
#include <hip/hip_runtime.h>
#include <cstdio>
#include <cstdint>
namespace pg8 {
#define PG8_LAS __attribute__((address_space(3)))
typedef unsigned short bf16_t;
typedef short bf16x8 __attribute__((ext_vector_type(8)));
typedef float f32x4 __attribute__((ext_vector_type(4)));
typedef unsigned u32x4 __attribute__((ext_vector_type(4)));
constexpr int BM = 256, BK = 64, HALF = 128, HTB = HALF * BK * 2  , STAGE_BYTES = 8 * HTB, NXCD = 8, WGM = 8;

__host__ __device__ __forceinline__ int lds_byte(int r, int c) { const int st = (r >> 4) * 2 + (c >> 5), rr = r & 15, cc = c & 31, ob = rr * 64 + cc * 2; return st * 1024 + (ob ^ (((ob >> 9) & 1) << 5)); }
__host__ __device__ __forceinline__ void stage_rc(int b, int& R, int& C) { const int st = b / 1024, sb = b % 1024, swz = sb ^ (((sb >> 9) & 1) << 5); R = (st >> 1) * 16 + swz / 64; C = (st & 1) * 32 + (swz % 64) / 2; }
__host__ __device__ __forceinline__ int perm32(int rho) { const int n = rho >> 4, i = rho & 15; return 8 * (i >> 2) + 4 * n + (i & 3); }

struct Unit { int pm, pn; };
struct Gemm { const bf16_t* A; const bf16_t* Bt; int M, N, K; };

struct StaticOrder {
    int nM, nN, nwg, G, c;
    __host__ __device__ void init(int M, int N, int G_, int c_) { nM = M / BM; nN = N / BM; nwg = nM * nN; G = G_; c = c_; }
    __host__ __device__ bool next(int i, Unit& u) const {
        const long L = (long)i * G + c; if (L >= nwg) return false;
        int wgid = (int)L; { const int q = nwg / NXCD, r = nwg % NXCD, xcd = wgid % NXCD, off = wgid / NXCD; wgid = (xcd < r ? xcd * (q + 1) : r * (q + 1) + (xcd - r) * q) + off; }
        const int nig = WGM * nN, gid = wgid / nig, fm = gid * WGM, gsz = (nM - fm) < WGM ? (nM - fm) : WGM;
        u.pm = fm + ((wgid % nig) % gsz); u.pn = (wgid % nig) / gsz; return true;
    }
    __device__ __forceinline__ void a_ready(const Unit&) const {}
    __device__ __forceinline__ void done(const Unit&) const {}
};

__device__ __forceinline__ unsigned cvt_pk_bf16(float lo, float hi) { unsigned r; asm volatile("v_cvt_pk_bf16_f32 %0, %1, %2" : "=v"(r) : "v"(lo), "v"(hi)); return r; }
typedef float f32x2 __attribute__((ext_vector_type(2)));
template <class Epi, class Sched, bool ALIGN_EPI = false, bool SP2 = false>
__device__ __forceinline__ void gemm_phase(PG8_LAS unsigned char* lds, const Gemm g, const Sched& S, const Epi& E) {
    const int tid = threadIdx.x, wid = __builtin_amdgcn_readfirstlane(tid >> 6), lane = tid & 63, wr = wid >> 2, wc = wid & 3, fr = lane & 15, fq = lane >> 4;
    const int K = g.K, nt = K / BK;
    unsigned voffA[2], voffB[2];
#pragma unroll
    for (int i = 0; i < 2; ++i) { int R, C; stage_rc(tid * 16 + i * 8192, R, C); const int Rb = Epi::PERM ? ((R & ~31) + perm32(R & 31)) : R;
        voffA[i] = (unsigned)(R * K + C) * 2u; voffB[i] = (unsigned)(Rb * K + C) * 2u; }
    const size_t kstep = (size_t)(BK * 2);
    const size_t hstep = (size_t)HALF * K * 2;
    const size_t tstep = 2 * hstep;
    const unsigned ldsw = (unsigned)wid * 1024u;
    const int aoff = lds_byte(wr * 64 + fr, fq * 8), boff = lds_byte(wc * 32 + fr, fq * 8);
#define PG8_SA(b, h) (((b) * 2 + (h)) * HTB)
#define PG8_SB(b, h) ((4 + (b) * 2 + (h)) * HTB)
#define PG8_STAGE(bufoff, gbase, voff) do { _Pragma("unroll") for (int _i = 0; _i < 2; ++_i) \
        __builtin_amdgcn_global_load_lds((const unsigned*)((const char*)(gbase) + (voff)[_i]), (PG8_LAS unsigned*)(lds + (bufoff) + ldsw + _i * 8192), 16, 0, 0); } while (0)
#define PG8_LDA(dst, b, h) do { _Pragma("unroll") for (int m = 0; m < 4; ++m) _Pragma("unroll") for (int k = 0; k < 2; ++k) dst[m][k] = *(const PG8_LAS bf16x8*)(lds + PG8_SA(b, h) + aoff + m * 2048 + k * 1024); } while (0)
#define PG8_LDB(dst, b, h) do { _Pragma("unroll") for (int n = 0; n < 2; ++n) _Pragma("unroll") for (int k = 0; k < 2; ++k) dst[n][k] = *(const PG8_LAS bf16x8*)(lds + PG8_SB(b, h) + boff + n * 2048 + k * 1024); } while (0)
#define PG8_MMA(ai, bj, At, Bt) do { __builtin_amdgcn_s_setprio(1); _Pragma("unroll") for (int m = 0; m < 4; ++m) _Pragma("unroll") for (int n = 0; n < 2; ++n) _Pragma("unroll") for (int k = 0; k < 2; ++k) \
        acc[ai][bj][m][n] = __builtin_amdgcn_mfma_f32_16x16x32_bf16(Bt[n][k], At[m][k], acc[ai][bj][m][n], 0, 0, 0); __builtin_amdgcn_s_setprio(0); } while (0)
#define PG8_WAIT_V(n) asm volatile("s_waitcnt vmcnt(" #n ")" ::: "memory")
#define PG8_WAIT_L(n) asm volatile("s_waitcnt lgkmcnt(" #n ")" ::: "memory")
#define PG8_BAR __builtin_amdgcn_s_barrier()
#define PG8_SCHED __builtin_amdgcn_sched_barrier(0)
    Unit cur, nxt; int ui = 0;
    if (!S.next(0, cur)) return;
    f32x4 acc[2][2][4][2];
#pragma unroll
    for (int a = 0; a < 2; ++a)
#pragma unroll
        for (int b = 0; b < 2; ++b)
#pragma unroll
            for (int m = 0; m < 4; ++m)
#pragma unroll
                for (int n = 0; n < 2; ++n) acc[a][b][m][n] = (f32x4){0.f, 0.f, 0.f, 0.f};
    bf16x8 At[4][2], B0[2][2], B1[2][2];
    const char* cA = (const char*)g.A + (size_t)cur.pm * tstep; const char* cB = (const char*)g.Bt + (size_t)cur.pn * tstep;
    S.a_ready(cur);
    if constexpr (SP2) {
        PG8_STAGE(PG8_SB(0, 0), cB, voffB); PG8_STAGE(PG8_SB(0, 1), cB + hstep, voffB); PG8_STAGE(PG8_SA(0, 0), cA, voffA); PG8_STAGE(PG8_SA(0, 1), cA + hstep, voffA);
        if (wr == 1) PG8_BAR;
        PG8_WAIT_V(2); PG8_BAR;
        PG8_STAGE(PG8_SB(1, 0), cB + kstep, voffB); PG8_STAGE(PG8_SA(1, 0), cA + kstep, voffA); PG8_STAGE(PG8_SB(1, 1), cB + hstep + kstep, voffB);
        PG8_WAIT_V(6); PG8_BAR;
    } else {
        PG8_STAGE(PG8_SB(0, 0), cB, voffB); PG8_STAGE(PG8_SA(0, 0), cA, voffA); PG8_STAGE(PG8_SB(0, 1), cB + hstep, voffB); PG8_STAGE(PG8_SA(0, 1), cA + hstep, voffA);
        if (wr == 1) PG8_BAR;
        PG8_WAIT_V(4); PG8_BAR;
        PG8_STAGE(PG8_SB(1, 0), cB + kstep, voffB); PG8_STAGE(PG8_SA(1, 0), cA + kstep, voffA); PG8_STAGE(PG8_SB(1, 1), cB + hstep + kstep, voffB);
        PG8_WAIT_V(6); PG8_BAR;
    }
    for (;;) {
        const bool has_next = S.next(ui + 1, nxt);
        const char* nA = has_next ? (const char*)g.A + (size_t)nxt.pm * tstep : cA; const char* nB = has_next ? (const char*)g.Bt + (size_t)nxt.pn * tstep : cB;
        for (int t = 0; t < nt; t += 2) {
            const bool last = (t == nt - 2);
            const char* a1 = cA + (size_t)(t + 1) * kstep;
            const char* a2 = last ? nA : cA + (size_t)(t + 2) * kstep; const char* b2 = last ? nB : cB + (size_t)(t + 2) * kstep;
            const char* a3 = a2 + kstep; const char* b3 = b2 + kstep;
            if (last && has_next) S.a_ready(nxt);
            if constexpr (SP2) {
            PG8_LDB(B0, 0, 0); PG8_LDB(B1, 0, 1); PG8_SCHED; PG8_LDA(At, 0, 0); PG8_STAGE(PG8_SA(1, 1), a1 + hstep, voffA);
            PG8_WAIT_V(8); PG8_WAIT_L(0); PG8_BAR; PG8_MMA(0, 0, At, B0); PG8_MMA(0, 1, At, B1); PG8_BAR; PG8_SCHED;
            PG8_LDA(At, 0, 1); PG8_STAGE(PG8_SB(0, 0), b2, voffB); PG8_STAGE(PG8_SB(0, 1), b2 + hstep, voffB); PG8_STAGE(PG8_SA(0, 0), a2, voffA);
            PG8_WAIT_V(8); PG8_WAIT_L(0); PG8_BAR; PG8_MMA(1, 0, At, B0); PG8_MMA(1, 1, At, B1); PG8_BAR; PG8_SCHED;
            PG8_LDB(B0, 1, 0); PG8_LDB(B1, 1, 1); PG8_SCHED; PG8_LDA(At, 1, 0); PG8_STAGE(PG8_SA(0, 1), a2 + hstep, voffA);
            PG8_WAIT_V(8); PG8_WAIT_L(0); PG8_BAR; PG8_MMA(0, 0, At, B0); PG8_MMA(0, 1, At, B1); PG8_BAR; PG8_SCHED;
            PG8_LDA(At, 1, 1); PG8_STAGE(PG8_SB(1, 0), b3, voffB); PG8_STAGE(PG8_SB(1, 1), b3 + hstep, voffB); PG8_STAGE(PG8_SA(1, 0), a3, voffA);
            PG8_WAIT_V(8); PG8_WAIT_L(0); PG8_BAR; PG8_MMA(1, 0, At, B0); PG8_MMA(1, 1, At, B1); PG8_BAR; PG8_SCHED;
            } else {
            PG8_LDB(B0, 0, 0); PG8_SCHED; PG8_LDA(At, 0, 0); PG8_STAGE(PG8_SA(1, 1), a1 + hstep, voffA);
            PG8_WAIT_L(8); PG8_BAR; PG8_WAIT_L(0); PG8_MMA(0, 0, At, B0); PG8_BAR; PG8_SCHED;
            PG8_LDB(B1, 0, 1); PG8_STAGE(PG8_SB(0, 0), b2, voffB);
            PG8_BAR; PG8_WAIT_L(0); PG8_MMA(0, 1, At, B1); PG8_BAR;
            PG8_LDA(At, 0, 1); PG8_STAGE(PG8_SA(0, 0), a2, voffA);
            PG8_BAR; PG8_WAIT_L(0); PG8_MMA(1, 0, At, B0); PG8_BAR; PG8_SCHED;
            PG8_STAGE(PG8_SB(0, 1), b2 + hstep, voffB);
            PG8_WAIT_V(6); PG8_BAR; PG8_MMA(1, 1, At, B1); PG8_BAR;
            PG8_LDB(B0, 1, 0); PG8_SCHED; PG8_LDA(At, 1, 0); PG8_STAGE(PG8_SA(0, 1), a2 + hstep, voffA);
            PG8_WAIT_L(8); PG8_BAR; PG8_WAIT_L(0); PG8_MMA(0, 0, At, B0); PG8_BAR; PG8_SCHED;
            PG8_LDB(B1, 1, 1); PG8_STAGE(PG8_SB(1, 0), b3, voffB);
            PG8_BAR; PG8_WAIT_L(0); PG8_MMA(0, 1, At, B1); PG8_BAR;
            PG8_LDA(At, 1, 1); PG8_STAGE(PG8_SA(1, 0), a3, voffA);
            PG8_BAR; PG8_WAIT_L(0); PG8_MMA(1, 0, At, B0); PG8_BAR; PG8_SCHED;
            PG8_STAGE(PG8_SB(1, 1), b3 + hstep, voffB);
            PG8_WAIT_V(6); PG8_BAR; PG8_MMA(1, 1, At, B1); PG8_BAR;
            }
        }
        if constexpr (ALIGN_EPI) { if (wr == 0) PG8_BAR; }
        if constexpr (!Epi::AFTER_DRAIN) { E(acc, cur, wr, wc, fr, fq); S.done(cur); }
        if (!has_next) break;
#pragma unroll
        for (int a = 0; a < 2; ++a)
#pragma unroll
            for (int b = 0; b < 2; ++b)
#pragma unroll
                for (int m = 0; m < 4; ++m)
#pragma unroll
                    for (int n = 0; n < 2; ++n) acc[a][b][m][n] = (f32x4){0.f, 0.f, 0.f, 0.f};
        cur = nxt; cA = nA; cB = nB; ++ui;
        if constexpr (ALIGN_EPI) { if (wr == 1) PG8_BAR; }
    }
    PG8_WAIT_V(0);
    if constexpr (!ALIGN_EPI) { if (wr == 0) PG8_BAR; }
    PG8_BAR;
    if constexpr (Epi::AFTER_DRAIN) { E.fused(acc, cur, wr, wc, fr, fq, lds, wid, lane); S.done(cur); }
#undef PG8_SA
#undef PG8_SB
#undef PG8_STAGE
#undef PG8_LDA
#undef PG8_LDB
#undef PG8_MMA
#undef PG8_WAIT_V
#undef PG8_WAIT_L
#undef PG8_BAR
#undef PG8_SCHED
}
}
constexpr int DM = 4096, SEQ = 2048, BP = 4, BS = 16, TS = 32, PAST = 1024;
constexpr int NPR = BP * SEQ, NSR = BS * TS, MR = NPR + NSR;
constexpr int DFF = 11008, N_AB = 12288, N_C = 5120, N_GU = 2 * DFF;
constexpr int W_AB = 2048;
constexpr int LA_S = PAST + TS, LB_S = 512 + TS, LC_S = 128 + TS;
constexpr float RMS_EPS = 1e-6f;
constexpr size_t O_Y_P = 0, O_Y_S = O_Y_P + (size_t)NPR * DM, O_SBK_P = O_Y_S + (size_t)NSR * DM, O_SBV_P = O_SBK_P + (size_t)NPR * W_AB,
                 O_BK_P = O_SBV_P + (size_t)NPR * W_AB, O_BV_P = O_BK_P + (size_t)BP * 512 * W_AB, O_CK_P = O_BV_P + (size_t)BP * 512 * W_AB, O_CV_P = O_CK_P + (size_t)BP * 128 * 512,
                 O_SBK_S = O_CV_P + (size_t)BP * 128 * 512, O_SBV_S = O_SBK_S + (size_t)NSR * W_AB, O_BK_S = O_SBV_S + (size_t)NSR * W_AB, O_BV_S = O_BK_S + (size_t)BS * 512 * W_AB,
                 O_CK_S = O_BV_S + (size_t)BS * 512 * W_AB, O_CV_S = O_CK_S + (size_t)BS * 128 * 512, O_END = O_CV_S + (size_t)BS * 128 * 512;
static_assert(O_END == 115867648, "output size");

namespace pg8 {
__device__ __forceinline__ u32x4 pack8(const f32x4& a, const f32x4& b) { u32x4 w; w.x = cvt_pk_bf16(a[0], a[1]); w.y = cvt_pk_bf16(a[2], a[3]); w.z = cvt_pk_bf16(b[0], b[1]); w.w = cvt_pk_bf16(b[2], b[3]); return w; }

struct EpiQKV0 {
    static constexpr bool PERM = true, AFTER_DRAIN = false;
    bf16_t* QKV; float* out; bf16_t *kAs, *vAs, *kBs, *vBs;
    __device__ __forceinline__ void operator()(const f32x4 (&acc)[2][2][4][2], const Unit& u, int wr, int wc, int fr, int fq) const {
        const int seg = u.pn >> 3, cs0 = (u.pn & 7) * 256 + wc * 32 + 8 * fq;
        const bool sample = u.pm >= 32;
        const bool isk = (seg == 1 || seg == 4), isv = (seg == 2 || seg == 5), isb = seg >= 3;
        float* fb = nullptr; bf16_t* sb = nullptr; int f_bs = 0, f_off = 0, s_len = 0, s_off = 0;
        if (isk || isv) {
            if (!sample) {
                if (!isb) fb = out + (isk ? O_SBK_P : O_SBV_P) + (size_t)(u.pm * 256) * W_AB;
                else if ((u.pm & 7) >= 6) fb = out + (isk ? O_BK_P : O_BV_P) + (size_t)((u.pm >> 3) * 512 + (u.pm & 7) * 256 - 1536) * W_AB;
            } else {
                if (!isb) { fb = out + (isk ? O_SBK_S : O_SBV_S); f_bs = TS; f_off = 0; sb = isk ? kAs : vAs; s_len = LA_S; s_off = PAST; }
                else      { fb = out + (isk ? O_BK_S : O_BV_S); f_bs = 512; f_off = 512 - TS; sb = isk ? kBs : vBs; s_len = LB_S; s_off = 512; }
            }
        }
#pragma unroll
        for (int ai = 0; ai < 2; ++ai)
#pragma unroll
            for (int m = 0; m < 4; ++m) {
                const int rl = ai * HALF + wr * 64 + m * 16 + fr; const size_t row = (size_t)u.pm * BM + rl;
                size_t frow = rl, srow = 0;
                if (sample) { const int r2 = (u.pm - 32) * 256 + rl, bs = r2 >> 5, t = r2 & 31; frow = (size_t)bs * f_bs + f_off + t; srow = (size_t)bs * s_len + s_off + t; }
#pragma unroll
                for (int bj = 0; bj < 2; ++bj) {
                    const int cs = cs0 + bj * HALF; const f32x4 v0 = acc[ai][bj][m][0], v1 = acc[ai][bj][m][1]; const u32x4 w = pack8(v0, v1);
                    *(u32x4*)(QKV + row * N_AB + seg * W_AB + cs) = w;
                    if (fb) { float* f = fb + frow * W_AB + cs; *(f32x4*)f = v0; *(f32x4*)(f + 4) = v1; }
                    if (sb) *(u32x4*)(sb + srow * W_AB + cs) = w;
                }
            }
    }
};
struct EpiQKV1 {
    static constexpr bool PERM = true, AFTER_DRAIN = false;
    bf16_t* QKV; float* out; bf16_t *kCs, *vCs; const float* rope;
    __device__ __forceinline__ void operator()(const f32x4 (&acc)[2][2][4][2], const Unit& u, int wr, int wc, int fr, int fq) const {
        const bool sample = u.pm >= 32; const int typ = u.pn < 16 ? 0 : (u.pn < 18 ? 1 : 2);
        const bool do_rope = (typ < 2) && ((wc & 1) == 0);
        const int cq0 = u.pn * 256 + wc * 32 + 8 * fq, ck0 = (u.pn & 1) * 256 + wc * 32 + 8 * fq;
        float* fb = nullptr; bf16_t* sb = nullptr;
        if (typ) { if (sample) { fb = out + (typ == 1 ? O_CK_S : O_CV_S); sb = typ == 1 ? kCs : vCs; } else if ((u.pm & 7) == 7) fb = out + (typ == 1 ? O_CK_P : O_CV_P) + (size_t)((u.pm >> 3) * 128) * 512; }
#pragma unroll
        for (int ai = 0; ai < 2; ++ai)
#pragma unroll
            for (int m = 0; m < 4; ++m) {
                const int rl = ai * HALF + wr * 64 + m * 16 + fr; const size_t row = (size_t)u.pm * BM + rl;
                int pos, bs = 0, t = 0; if (sample) { const int r2 = (u.pm - 32) * 256 + rl; bs = r2 >> 5; t = r2 & 31; pos = PAST + t; } else pos = (u.pm & 7) * 256 + rl;
                f32x4 cs0v, cs1v, sn0v, sn1v;
                if (do_rope) { const f32x4* rp = (const f32x4*)(rope + (size_t)pos * 16); cs0v = rp[0]; cs1v = rp[1]; sn0v = rp[2]; sn1v = rp[3]; if (fq == 0) { sn0v = -sn0v; sn1v = -sn1v; } }
#pragma unroll
                for (int bj = 0; bj < 2; ++bj) {
                    f32x4 v0 = acc[ai][bj][m][0], v1 = acc[ai][bj][m][1];
                    if (do_rope) {
                        f32x4 p0, p1;
#pragma unroll
                        for (int j = 0; j < 4; ++j) { p0[j] = __shfl_xor(v0[j], 16); p1[j] = __shfl_xor(v1[j], 16); }
                        if (fq < 2) { v0 = v0 * cs0v + p0 * sn0v; v1 = v1 * cs1v + p1 * sn1v; }
                    }
                    const u32x4 w = pack8(v0, v1);
                    if (typ == 0 || !sample) *(u32x4*)(QKV + row * N_C + cq0 + bj * HALF) = w;
                    if (typ) {
                        const int cs = ck0 + bj * HALF;
                        if (sample) { float* f = fb + ((size_t)bs * 128 + (128 - TS) + t) * 512 + cs; *(f32x4*)f = v0; *(f32x4*)(f + 4) = v1; *(u32x4*)(sb + ((size_t)bs * LC_S + 128 + t) * 512 + cs) = w; }
                        else if (fb && ai == 1) { float* f = fb + (size_t)(rl - 128) * 512 + cs; *(f32x4*)f = v0; *(f32x4*)(f + 4) = v1; }
                    }
                }
            }
    }
};
struct EpiResid {
    static constexpr bool PERM = false, AFTER_DRAIN = false;
    const float* rp; const float* rs; float* H;
    __device__ __forceinline__ void operator()(const f32x4 (&acc)[2][2][4][2], const Unit& u, int wr, int wc, int fr, int fq) const {
        const int col0 = u.pn * BM + wc * 32 + 4 * fq;
#pragma unroll
        for (int ai = 0; ai < 2; ++ai)
#pragma unroll
            for (int m = 0; m < 4; ++m) {
                const size_t row = (size_t)u.pm * BM + ai * HALF + wr * 64 + m * 16 + fr;
                const float* src = (u.pm < 32 ? rp + row * DM : rs + (row - NPR) * DM) + col0; float* dst = H + row * DM + col0;
#pragma unroll
                for (int bj = 0; bj < 2; ++bj)
#pragma unroll
                    for (int n = 0; n < 2; ++n) *(f32x4*)(dst + bj * HALF + n * 16) = *(const f32x4*)(src + bj * HALF + n * 16) + acc[ai][bj][m][n];
            }
    }
};
struct EpiSwiGLU {
    static constexpr bool PERM = true, AFTER_DRAIN = false;
    bf16_t* ACT;
    __device__ __forceinline__ void operator()(const f32x4 (&acc)[2][2][4][2], const Unit& u, int wr, int wc, int fr, int fq) const {
        const int col0 = u.pn * HALF + wc * 32 + 8 * fq;
#pragma unroll
        for (int ai = 0; ai < 2; ++ai)
#pragma unroll
            for (int m = 0; m < 4; ++m) {
                const size_t row = (size_t)u.pm * BM + ai * HALF + wr * 64 + m * 16 + fr;
                f32x4 r[2];
#pragma unroll
                for (int n = 0; n < 2; ++n)
#pragma unroll
                    for (int j = 0; j < 4; ++j) { const float g = acc[ai][0][m][n][j], up = acc[ai][1][m][n][j]; r[n][j] = g * __builtin_amdgcn_rcpf(1.0f + __builtin_amdgcn_exp2f(-1.4426950408889634f * g)) * up; }
                *(u32x4*)(ACT + row * DFF + col0) = pack8(r[0], r[1]);
            }
    }
};
}
#define PG8_SP2 true
#define PG8_ALIGN true
constexpr int NWAVES = 8;
constexpr int N_PHASES = 15;
#ifndef MK_PER_PHASE
#define MK_PER_PHASE 1
#endif
constexpr size_t MiB = 1u << 20;
constexpr size_t WS_CTL = 0, CTL_ZERO_BYTES = 1 * MiB;
constexpr size_t WS_ROPE = 1 * MiB;
constexpr size_t WS_W_IN = 2 * MiB, WS_W_OUTAB = 98 * MiB, WS_W_QKVC = 130 * MiB, WS_W_OUTC = 170 * MiB;
constexpr size_t WS_W_GU0 = 202 * MiB, WS_W_GU1 = 374 * MiB, WS_W_DN0 = 546 * MiB, WS_W_DN1 = 632 * MiB;
constexpr size_t WS_H = 718 * MiB;
constexpr size_t WS_XN = 854 * MiB;
constexpr size_t WS_QKV = 922 * MiB;
constexpr size_t WS_ATT = 1126 * MiB;
constexpr size_t WS_ACT = 1194 * MiB;
constexpr size_t WS_KAS = 1377 * MiB, WS_VAS = 1443 * MiB, WS_KBS = 1509 * MiB, WS_VBS = 1543 * MiB, WS_KCS = 1577 * MiB, WS_VCS = 1580 * MiB;
constexpr size_t WS_END = 1583 * MiB;
static_assert(WS_W_IN + (size_t)N_AB * DM * 2 <= WS_W_OUTAB && WS_W_OUTAB + (size_t)DM * DM * 2 <= WS_W_QKVC && WS_W_QKVC + (size_t)N_C * DM * 2 <= WS_W_OUTC && WS_W_OUTC + (size_t)DM * DM * 2 <= WS_W_GU0, "ws map 1");
static_assert(WS_W_GU0 + (size_t)N_GU * DM * 2 <= WS_W_GU1 && WS_W_GU1 + (size_t)N_GU * DM * 2 <= WS_W_DN0 && WS_W_DN0 + (size_t)DM * DFF * 2 <= WS_W_DN1 && WS_W_DN1 + (size_t)DM * DFF * 2 <= WS_H, "ws map 2");
static_assert(WS_H + (size_t)MR * DM * 4 <= WS_XN && WS_XN + (size_t)MR * DM * 2 <= WS_QKV && WS_QKV + (size_t)MR * N_AB * 2 <= WS_ATT && WS_ATT + (size_t)MR * DM * 2 <= WS_ACT && WS_ACT + (size_t)MR * DFF * 2 <= WS_KAS, "ws map 3");
static_assert(WS_KAS + (size_t)BS * LA_S * W_AB * 2 <= WS_VAS && WS_VAS + (size_t)BS * LA_S * W_AB * 2 <= WS_KBS && WS_KBS + (size_t)BS * LB_S * W_AB * 2 <= WS_VBS && WS_VBS + (size_t)BS * LB_S * W_AB * 2 <= WS_KCS &&
              WS_KCS + (size_t)BS * LC_S * 512 * 2 <= WS_VCS && WS_VCS + (size_t)BS * LC_S * 512 * 2 <= WS_END, "ws map 4");
constexpr int CW_BAR = 4096;
constexpr int RING_OFF = 0, RING_BYTES = 131072;
constexpr int LDSCTL_OFF = RING_BYTES, MISC_OFF = LDSCTL_OFF + 320;
constexpr int LDS_BYTES = 147456;
static_assert(MISC_OFF + 128 <= LDS_BYTES, "LDS map");
#define GAS __attribute__((address_space(1)))
#define LAS __attribute__((address_space(3)))
typedef unsigned short bf16;
typedef unsigned v4u __attribute__((ext_vector_type(4)));
typedef float f32x4 __attribute__((ext_vector_type(4)));
typedef short bf16x8 __attribute__((ext_vector_type(8)));
typedef GAS unsigned gu32;
typedef GAS unsigned long long gu64;
#define RLX_AGENT __ATOMIC_RELAXED, __HIP_MEMORY_SCOPE_AGENT
#define LDS_WAIT() asm volatile("s_waitcnt lgkmcnt(0)" ::: "memory")
#define VM_WAIT() asm volatile("s_waitcnt vmcnt(0)" ::: "memory")
__device__ __forceinline__ unsigned long long rt() { return __builtin_amdgcn_s_memrealtime(); }
__device__ __forceinline__ unsigned f2bf(float f) { unsigned u = __builtin_bit_cast(unsigned, f); return (u + 0x7fffu + ((u >> 16) & 1u)) >> 16; }
__device__ __forceinline__ unsigned pk2(float lo, float hi) { return f2bf(lo) | (f2bf(hi) << 16); }

#define XB_TMO      128
#define XB_XCNT(j)  (256  + 64 * (j))
#define XB_XSUB(j)  (1280 + 64 * (j))
#define XB_XGEN(j)  (2304 + 64 * (j))
#define XB_TOP      3328
#define XB_TOPGEN   3392
#define XCD_BAR_WORDS 3456
#define XB_SPIN_CAP (1u << 18)

__device__ __forceinline__ unsigned xb_ld(unsigned* p)              { return __hip_atomic_load(p, __ATOMIC_RELAXED, __HIP_MEMORY_SCOPE_AGENT); }
__device__ __forceinline__ unsigned xb_add(unsigned* p, unsigned v) { return __hip_atomic_fetch_add(p, v, __ATOMIC_RELAXED, __HIP_MEMORY_SCOPE_AGENT); }
__device__ __forceinline__ unsigned xb_xcc_id() { return (unsigned)__builtin_amdgcn_s_getreg((3 << 11) | 20) & 0xFu; }
#define XB_SPIN(cond, bar) do { unsigned _sp = 0; while (cond) { __builtin_amdgcn_s_sleep(1); \
    if ((++_sp & 255u) == 0u) { if (xb_ld(&(bar)[XB_TMO])) break; if (_sp > XB_SPIN_CAP) { atomicAdd(&(bar)[XB_TMO], 1u); break; } } } } while (0)

struct XcdBarrier {
    unsigned* bar; unsigned x;
    volatile LAS unsigned* st;
};

__device__ __forceinline__ XcdBarrier xcd_barrier_post(unsigned* bar, volatile LAS unsigned* st) {
    XcdBarrier b; b.bar = bar; b.x = xb_xcc_id(); b.st = st;
    if (threadIdx.x == 0) (void)xb_add(&bar[XB_XCNT(b.x)], 1u);
    return b;
}
__device__ __forceinline__ void xcd_barrier_complete(unsigned* bar, unsigned x, unsigned& nloc, unsigned& nx) {
    const unsigned G = gridDim.x * gridDim.y * gridDim.z;
    unsigned sum, cnt, mine, sp = 0u;
    for (;;) {
        sum = 0u; cnt = 0u; mine = 0u;
#pragma unroll
        for (unsigned j = 0; j < 16; ++j) { const unsigned c = xb_ld(&bar[XB_XCNT(j)]); sum += c; cnt += (c > 0u) ? 1u : 0u; mine = (j == x) ? c : mine; }
        if (sum == G) break;
        __builtin_amdgcn_s_sleep(1);
        if ((++sp & 255u) == 0u) { if (xb_ld(&bar[XB_TMO])) break; if (sp > XB_SPIN_CAP) { atomicAdd(&bar[XB_TMO], 1u); break; } }
    }
    nloc = mine > 0u ? mine : 1u; nx = cnt > 0u ? cnt : 1u;
}

__device__ __forceinline__ void xcd_barrier(const XcdBarrier& b) {
    asm volatile("s_waitcnt vmcnt(0)" ::: "memory");
    __syncthreads();
    if (threadIdx.x == 0) {
        unsigned* bar = b.bar;
        __builtin_amdgcn_s_waitcnt(0);
        unsigned nloc = b.st[0], nx = b.st[1];
        if (nloc == 0u) { xcd_barrier_complete(bar, b.x, nloc, nx); b.st[0] = nloc; b.st[1] = nx; }
        const unsigned old = xb_add(&bar[XB_XSUB(b.x)], 1u);
        const unsigned gen = old / nloc;
        if (old + 1u == (gen + 1u) * nloc) {
            __builtin_amdgcn_fence(__ATOMIC_RELEASE, "agent");
            asm volatile("s_waitcnt vmcnt(0)" ::: "memory");
            const unsigned og = xb_add(&bar[XB_TOP], 1u);
            const unsigned tg = og / nx;
            if (og + 1u == (tg + 1u) * nx) xb_add(&bar[XB_TOPGEN], 1u);
            else XB_SPIN(xb_ld(&bar[XB_TOPGEN]) == tg, bar);
            __builtin_amdgcn_fence(__ATOMIC_ACQUIRE, "agent");
            xb_add(&bar[XB_XGEN(b.x)], 1u);
            asm volatile("s_waitcnt vmcnt(0)" ::: "memory");
        } else {
            XB_SPIN(xb_ld(&bar[XB_XGEN(b.x)]) == gen, bar);
            __builtin_amdgcn_fence(__ATOMIC_ACQUIRE, "agent");
            asm volatile("s_waitcnt vmcnt(0)" ::: "memory");
        }
    }
    __syncthreads();
}

struct Frame {
    LAS unsigned char* lds;
    volatile LAS unsigned* MISC;
    gu32* ctl;
    int tid, lane, wave;
    int vcu, G;
};
__device__ __forceinline__ float wave_sum(float v) {
#pragma unroll
    for (int o = 1; o < 64; o <<= 1) v += __shfl_xor(v, o);
    return v;
}
__device__ __forceinline__ float wave_max(float v) {
#pragma unroll
    for (int o = 1; o < 64; o <<= 1) v = fmaxf(v, __shfl_xor(v, o));
    return v;
}
__device__ __forceinline__ float bflo(unsigned w) { return __builtin_bit_cast(float, w << 16); }
__device__ __forceinline__ float bfhi(unsigned w) { return __builtin_bit_cast(float, w & 0xffff0000u); }

__device__ __forceinline__ void p0_transpose_item(const float* W, int K, int N, bf16* WT, int k0, int n0, int drow0, LAS float* scr, int lane) {
#pragma unroll 8
    for (int i = 0; i < 32; ++i) { const int kk = 2 * i + (lane >> 5); scr[kk * 33 + (lane & 31)] = W[(size_t)(k0 + kk) * N + n0 + (lane & 31)]; }
    LDS_WAIT(); asm volatile("" ::: "memory");
    const int c = lane & 7;
#pragma unroll
    for (int j = 0; j < 4; ++j) { const int n = (lane >> 3) + 8 * j; const LAS float* s = scr + (8 * c) * 33 + n;
        v4u o; o.x = pk2(s[0 * 33], s[1 * 33]); o.y = pk2(s[2 * 33], s[3 * 33]); o.z = pk2(s[4 * 33], s[5 * 33]); o.w = pk2(s[6 * 33], s[7 * 33]);
        *(v4u*)(WT + (size_t)(drow0 + n) * K + k0 + 8 * c) = o; }
    LDS_WAIT(); asm volatile("" ::: "memory");
}
template <bool OUT_F32>
__device__ __forceinline__ void rms_row(const float* xrow, const float* g, void* orow, int lane) {
    f32x4 v[16]; float s = 0.f;
#pragma unroll
    for (int j = 0; j < 8; ++j) { const f32x4* p = (const f32x4*)(xrow + j * 512 + lane * 8); v[2 * j] = p[0]; v[2 * j + 1] = p[1]; }
#pragma unroll
    for (int j = 0; j < 16; ++j) s += (v[j].x * v[j].x + v[j].y * v[j].y) + (v[j].z * v[j].z + v[j].w * v[j].w);
    const float r = 1.0f / sqrtf(wave_sum(s) * (1.0f / DM) + RMS_EPS);
#pragma unroll
    for (int j = 0; j < 8; ++j) { const f32x4* gp = (const f32x4*)(g + j * 512 + lane * 8); const f32x4 a = v[2 * j] * r * gp[0], b = v[2 * j + 1] * r * gp[1];
        if (OUT_F32) { f32x4* o = (f32x4*)((float*)orow + j * 512 + lane * 8); o[0] = a; o[1] = b; }
        else { v4u w; w.x = pk2(a.x, a.y); w.y = pk2(a.z, a.w); w.z = pk2(b.x, b.y); w.w = pk2(b.z, b.w); *(v4u*)((bf16*)orow + j * 512 + lane * 8) = w; } }
}
__device__ __forceinline__ v4u cvt8(const float* p) { const f32x4 a = *(const f32x4*)p, b = *(const f32x4*)(p + 4); v4u w; w.x = pk2(a.x, a.y); w.y = pk2(a.z, a.w); w.z = pk2(b.x, b.y); w.w = pk2(b.z, b.w); return w; }

struct Args { const float* in[20]; float* out; unsigned char* ws; int ph_lo, ph_hi; };
static_assert(sizeof(Args) == 22 * 8 + 8, "Args has no padding");

__device__ __forceinline__ void p0_prologue(Frame& F, const Args& A) {
    unsigned char* ws = A.ws;
    LAS float* scr = (LAS float*)(F.lds + RING_OFF + F.wave * 16384);
    const int gw = F.vcu * NWAVES + F.wave, NGW = F.G * NWAVES;
    constexpr int I_IN = 64 * (N_AB / 32), I_O = 64 * (DM / 32), I_QC = 64 * (N_C / 32), I_G = 64 * (DFF / 32), I_D = (DFF / 64) * (DM / 32);
    constexpr int NITEMS = I_IN + 2 * I_O + I_QC + 4 * I_G + 2 * I_D;
    for (int it = gw; it < NITEMS; it += NGW) {
        int r = it; const float* W; bf16* WT; int K = DM, N; int mode = 0;
        if (r < I_IN) { W = A.in[11]; WT = (bf16*)(ws + WS_W_IN); N = N_AB; }
        else if ((r -= I_IN) < I_O) { W = A.in[12]; WT = (bf16*)(ws + WS_W_OUTAB); N = DM; }
        else if ((r -= I_O) < I_QC) { W = A.in[14]; WT = (bf16*)(ws + WS_W_QKVC); N = N_C; }
        else if ((r -= I_QC) < I_O) { W = A.in[15]; WT = (bf16*)(ws + WS_W_OUTC); N = DM; }
        else if ((r -= I_O) < 2 * I_G) { const int l = r / I_G; r -= l * I_G; W = A.in[17] + (size_t)l * DM * DFF; WT = (bf16*)(ws + (l ? WS_W_GU1 : WS_W_GU0)); N = DFF; mode = 1; }
        else if ((r -= 2 * I_G) < 2 * I_G) { const int l = r / I_G; r -= l * I_G; W = A.in[18] + (size_t)l * DM * DFF; WT = (bf16*)(ws + (l ? WS_W_GU1 : WS_W_GU0)); N = DFF; mode = 2; }
        else { r -= 2 * I_G; const int l = r / I_D; r -= l * I_D; W = A.in[19] + (size_t)l * DFF * DM; WT = (bf16*)(ws + (l ? WS_W_DN1 : WS_W_DN0)); N = DM; K = DFF; }
        const int nblk = N / 32, kb = r / nblk, nb = r % nblk, n0 = 32 * nb;
        const int drow0 = mode == 0 ? n0 : (256 * (n0 >> 7) + (n0 & 127) + (mode == 2 ? 128 : 0));
        p0_transpose_item(W, K, N, WT, 64 * kb, n0, drow0, scr, F.lane);
    }
    const size_t gt = (size_t)F.vcu * (NWAVES * 64) + F.tid, NGT = (size_t)F.G * (NWAVES * 64);
    for (int kv = 0; kv < 2; ++kv) {
        const float* cA = A.in[2 + kv]; bf16* dA = (bf16*)(ws + (kv ? WS_VAS : WS_KAS));
        for (size_t i = gt; i < (size_t)BS * PAST * W_AB / 8; i += NGT) { const size_t e = i * 8, bs = e / ((size_t)PAST * W_AB), rem = e % ((size_t)PAST * W_AB); *(v4u*)(dA + bs * LA_S * W_AB + rem) = cvt8(cA + e); }
        const float* cB = A.in[4 + kv]; bf16* dB = (bf16*)(ws + (kv ? WS_VBS : WS_KBS)); float* oB = A.out + (kv ? O_BV_S : O_BK_S);
        for (size_t i = gt; i < (size_t)BS * 512 * W_AB / 8; i += NGT) { const size_t e = i * 8, bs = e / ((size_t)512 * W_AB), rem = e % ((size_t)512 * W_AB); const size_t rr = rem / W_AB;
            *(v4u*)(dB + bs * LB_S * W_AB + rem) = cvt8(cB + e);
            if (rr >= TS) { float* o = oB + e - (size_t)TS * W_AB; *(f32x4*)o = *(const f32x4*)(cB + e); *(f32x4*)(o + 4) = *(const f32x4*)(cB + e + 4); } }
        const float* cC = A.in[6 + kv]; bf16* dC = (bf16*)(ws + (kv ? WS_VCS : WS_KCS)); float* oC = A.out + (kv ? O_CV_S : O_CK_S);
        for (size_t i = gt; i < (size_t)BS * 128 * 512 / 8; i += NGT) { const size_t e = i * 8, bs = e / ((size_t)128 * 512), rem = e % ((size_t)128 * 512); const size_t rr = rem / 512;
            *(v4u*)(dC + bs * LC_S * 512 + rem) = cvt8(cC + e);
            if (rr >= TS) { float* o = oC + e - (size_t)TS * 512; *(f32x4*)o = *(const f32x4*)(cC + e); *(f32x4*)(o + 4) = *(const f32x4*)(cC + e + 4); } }
    }
    { float* rope = (float*)(ws + WS_ROPE);
      for (size_t i = gt; i < (size_t)SEQ * 8; i += NGT) { const int pos = (int)(i >> 3), fi = (int)(i & 7); const float inv = powf(500000.0f, -(float)fi / 8.0f); const float ang = (float)pos * inv;
          rope[pos * 16 + fi] = (float)cos((double)ang); rope[pos * 16 + 8 + fi] = (float)sin((double)ang); } }
    for (int m = gw; m < MR; m += NGW) rms_row<false>(m < NPR ? A.in[0] + (size_t)m * DM : A.in[1] + (size_t)(m - NPR) * DM, A.in[8], (bf16*)(ws + WS_XN) + (size_t)m * DM, F.lane);
}
__device__ __forceinline__ void rms_phase(Frame& F, const float* H, const float* g, bf16* XN) {
    const int gw = F.vcu * NWAVES + F.wave, NGW = F.G * NWAVES;
    for (int m = gw; m < MR; m += NGW) rms_row<false>(H + (size_t)m * DM, g, XN + (size_t)m * DM, F.lane);
}
template <int D> __device__ __forceinline__ float naive_dot(const bf16* kr, const LAS float* qs) {
    float s = 0.f;
#pragma unroll
    for (int c = 0; c < D / 8; ++c) { const v4u kv = *(const v4u*)(kr + 8 * c); const f32x4 qa = *(const LAS f32x4*)(qs + 8 * c), qb = *(const LAS f32x4*)(qs + 8 * c + 4);
        s += bflo(kv.x) * qa.x + bfhi(kv.x) * qa.y + bflo(kv.y) * qa.z + bfhi(kv.y) * qa.w + bflo(kv.z) * qb.x + bfhi(kv.z) * qb.y + bflo(kv.w) * qb.z + bfhi(kv.w) * qb.w; }
    return s;
}
template <int D> __device__ __forceinline__ void naive_stage_q(const bf16* q, LAS float* qs, int lane) {
    if (D == 128) { const unsigned w = *(const unsigned*)(q + 2 * lane); qs[2 * lane] = bflo(w); qs[2 * lane + 1] = bfhi(w); }
    else { qs[lane] = __builtin_bit_cast(float, (unsigned)q[lane] << 16); }
    LDS_WAIT(); asm volatile("" ::: "memory");
}
template <int D> __device__ __forceinline__ void naive_pv(const bf16* vbase, long stride, int j0, int jmax, float p, float& o0, float& o1, int lane) {
    for (int s0 = 0; s0 < 64; s0 += 8) {
        unsigned w[8];
#pragma unroll
        for (int i = 0; i < 8; ++i) { const int jj = (j0 + s0 + i) < jmax ? (j0 + s0 + i) : jmax; const bf16* vr = vbase + (long)jj * stride;
            if (D == 128) w[i] = *(const unsigned*)(vr + 2 * lane); else w[i] = (unsigned)vr[lane] << 16; }
#pragma unroll
        for (int i = 0; i < 8; ++i) { const float ps = __shfl(p, s0 + i);
            if (D == 128) { o0 += ps * bflo(w[i]); o1 += ps * bfhi(w[i]); } else o0 += ps * __builtin_bit_cast(float, w[i]); }
    }
}
template <int D> __device__ __forceinline__ void naive_store_o(bf16* o, float o0, float o1, int lane) {
    if (D == 128) *(unsigned*)(o + 2 * lane) = pk2(o0, o1); else o[lane] = (bf16)f2bf(o0);
}
template <int D> __device__ __forceinline__ void naive_softmax_query(const bf16* q, const bf16* kbase, const bf16* vbase, long stride, int nk, int qpos, int kpos0,
                                                                     const float* bias_tab, bool has_sink, float sink, bf16* o, LAS float* qs, int lane) {
    naive_stage_q<D>(q, qs, lane);
    const float scale = D == 128 ? 0.08838834764831845f : 0.125f;
    float m = -INFINITY, l = 0.f, o0 = 0.f, o1 = 0.f;
    for (int j0 = 0; j0 < nk; j0 += 64) {
        const int j = j0 + lane; const bool ok = j < nk; const int jc = ok ? j : nk - 1;
        float s = naive_dot<D>(kbase + (long)jc * stride, qs) * scale;
        if (bias_tab) { int d = qpos - (kpos0 + jc); d = d < -128 ? -128 : (d > 128 ? 128 : d); s += bias_tab[d + 128]; }
        if (!ok) s = -INFINITY;
        const float mn = fmaxf(m, wave_max(s)), alpha = __expf(m - mn), p = ok ? __expf(s - mn) : 0.f;
        l = l * alpha + wave_sum(p); o0 *= alpha; o1 *= alpha; m = mn;
        naive_pv<D>(vbase, stride, j0, nk - 1, p, o0, o1, lane);
    }
    if (has_sink) { const float mn = fmaxf(m, sink), alpha = __expf(m - mn); l = l * alpha + __expf(sink - mn); o0 *= alpha; o1 *= alpha; }
    const float inv = 1.0f / l;
    naive_store_o<D>(o, o0 * inv, o1 * inv, lane);
    LDS_WAIT(); asm volatile("" ::: "memory");
}
__device__ __forceinline__ void naive_sb_query(const bf16* q, const bf16* kbase, const bf16* vbase, long stride, int nvalid, bf16* o, LAS float* qs, int lane) {
    naive_stage_q<128>(q, qs, lane);
    float R = 0.f, o0 = 0.f, o1 = 0.f;
    for (int blk = (nvalid + 63) / 64 - 1; blk >= 0; --blk) {
        const int j0 = blk * 64, j = j0 + lane; const bool ok = j < nvalid; const int jc = ok ? j : nvalid - 1;
        const float z = naive_dot<128>(kbase + (long)jc * stride, qs) * 0.08838834764831845f;
        const float sp = fmaxf(z, 0.f) + log1pf(__expf(-fabsf(z)));
        const float l1m = ok ? -sp : 0.f;
        float x = l1m;
#pragma unroll
        for (int off = 1; off < 64; off <<= 1) { const float y = __shfl_down(x, off); if (lane + off < 64) x += y; }
        const float w = ok ? __expf((z - sp) + (x - l1m) + R) : 0.f;
        R += __shfl(x, 0);
        naive_pv<128>(vbase, stride, j0, nvalid - 1, w, o0, o1, lane);
    }
    naive_store_o<128>(o, o0, o1, lane);
    LDS_WAIT(); asm volatile("" ::: "memory");
}
__device__ __forceinline__ void naive_attn0(Frame& F, const Args& A) {
    unsigned char* ws = A.ws; const bf16* QKV = (const bf16*)(ws + WS_QKV); bf16* ATT = (bf16*)(ws + WS_ATT);
    LAS float* qs = (LAS float*)(F.lds + RING_OFF + F.wave * 1024);
    const int gw = F.vcu * NWAVES + F.wave, NGW = F.G * NWAVES;
    constexpr int T_PA = NPR * 16, T_PB = NPR * 16, T_SA = NSR * 16, T_SB = NSR * 16;
    for (int task = gw; task < T_PA + T_PB + T_SA + T_SB; task += NGW) {
        int r = task;
        if (r < T_PA) { const int h = r & 15, row = r >> 4, b = row >> 11, t = row & 2047; const bf16* base = QKV + (size_t)(b * SEQ) * N_AB + h * 128;
            naive_sb_query(QKV + (size_t)row * N_AB + h * 128, base + W_AB, base + 2 * W_AB, N_AB, t, ATT + (size_t)row * DM + h * 128, qs, F.lane); continue; }
        r -= T_PA;
        if (r < T_PB) { const int h = r & 15, row = r >> 4, b = row >> 11, t = row & 2047, c = t >> 6, c0 = c >= 8 ? c - 8 : 0; const bf16* base = QKV + (size_t)(b * SEQ + c0 * 64) * N_AB + h * 128;
            naive_softmax_query<128>(QKV + (size_t)row * N_AB + 3 * W_AB + h * 128, base + 4 * W_AB, base + 5 * W_AB, N_AB, (c + 1 - c0) * 64, t, c0 * 64, A.in[13] + h * 257, false, 0.f,
                                     ATT + (size_t)row * DM + W_AB + h * 128, qs, F.lane); continue; }
        r -= T_PB;
        if (r < T_SA) { const int h = r & 15, r2 = r >> 4, bs = r2 >> 5, t = r2 & 31; const size_t row = NPR + r2;
            naive_sb_query(QKV + row * N_AB + h * 128, (const bf16*)(ws + WS_KAS) + (size_t)bs * LA_S * W_AB + h * 128, (const bf16*)(ws + WS_VAS) + (size_t)bs * LA_S * W_AB + h * 128, W_AB, PAST + t,
                           ATT + row * DM + h * 128, qs, F.lane); continue; }
        r -= T_SA;
        { const int h = r & 15, r2 = r >> 4, bs = r2 >> 5, t = r2 & 31; const size_t row = NPR + r2;
            naive_softmax_query<128>(QKV + row * N_AB + 3 * W_AB + h * 128, (const bf16*)(ws + WS_KBS) + (size_t)bs * LB_S * W_AB + h * 128, (const bf16*)(ws + WS_VBS) + (size_t)bs * LB_S * W_AB + h * 128, W_AB, LB_S,
                                     PAST + t, PAST - 512, A.in[13] + h * 257, false, 0.f, ATT + row * DM + W_AB + h * 128, qs, F.lane); }
    }
}
__device__ __forceinline__ void naive_attn1(Frame& F, const Args& A) {
    unsigned char* ws = A.ws; const bf16* QKV = (const bf16*)(ws + WS_QKV); bf16* ATT = (bf16*)(ws + WS_ATT);
    LAS float* qs = (LAS float*)(F.lds + RING_OFF + F.wave * 1024);
    const int gw = F.vcu * NWAVES + F.wave, NGW = F.G * NWAVES;
    constexpr int T_P = NPR * 64, T_S = NSR * 64;
    for (int task = gw; task < T_P + T_S; task += NGW) {
        int r = task;
        if (r < T_P) { const int h = r & 63, row = r >> 6, b = row >> 11, t = row & 2047, c = t >> 6, c0 = c >= 2 ? c - 2 : 0; const bf16* base = QKV + (size_t)(b * SEQ + c0 * 64) * N_C + (h >> 3) * 64;
            naive_softmax_query<64>(QKV + (size_t)row * N_C + h * 64, base + 4096, base + 4608, N_C, (c + 1 - c0) * 64, t, c0 * 64, nullptr, true, A.in[16][h], ATT + (size_t)row * DM + h * 64, qs, F.lane); continue; }
        r -= T_P;
        { const int h = r & 63, r2 = r >> 6, bs = r2 >> 5; const size_t row = NPR + r2;
            naive_softmax_query<64>(QKV + row * N_C + h * 64, (const bf16*)(ws + WS_KCS) + (size_t)bs * LC_S * 512 + (h >> 3) * 64, (const bf16*)(ws + WS_VCS) + (size_t)bs * LC_S * 512 + (h >> 3) * 64, 512, LC_S,
                                    0, 0, nullptr, true, A.in[16][h], ATT + row * DM + h * 64, qs, F.lane); }
    }
}
__global__ void __launch_bounds__(NWAVES * 64, 2) fwd(Args args) {
    extern __shared__ __attribute__((aligned(16))) unsigned char lds[];
    Frame F;
    F.lds = (LAS unsigned char*)lds;
    F.MISC = (volatile LAS unsigned*)(F.lds + MISC_OFF);
    F.tid = threadIdx.x; F.lane = F.tid & 63; F.wave = __builtin_amdgcn_readfirstlane(F.tid >> 6);
    F.G = gridDim.x; { const int bx = blockIdx.x; F.vcu = (F.G % 8 == 0) ? (bx % 8) * (F.G / 8) + bx / 8 : bx; }
    unsigned char* ws = args.ws;
    F.ctl = (gu32*)(ws + WS_CTL);
    for (int u = F.tid; u < (LDS_BYTES - LDSCTL_OFF) / 4; u += NWAVES * 64) ((LAS unsigned*)(F.lds + LDSCTL_OFF))[u] = 0u;
    __syncthreads();
    XcdBarrier bar; bar.bar = (unsigned*)(F.ctl + CW_BAR); bar.x = 0; bar.st = nullptr;
    if (!MK_PER_PHASE) bar = xcd_barrier_post((unsigned*)(F.ctl + CW_BAR), F.MISC + 8);
#define GRID_BAR() do { if (!MK_PER_PHASE) xcd_barrier(bar); } while (0)
    const int lo = args.ph_lo, hi = args.ph_hi;
#define IN(k) (lo <= (k) && (k) < hi)
#define BOTH(k) (IN(k) && IN((k) + 1))
    bf16* XN = (bf16*)(ws + WS_XN); bf16* QKV = (bf16*)(ws + WS_QKV); bf16* ATT = (bf16*)(ws + WS_ATT); bf16* ACT = (bf16*)(ws + WS_ACT); float* H = (float*)(ws + WS_H);
    LAS unsigned char* ring = F.lds + RING_OFF;

    if (IN(0)) { p0_prologue(F, args); if (BOTH(0)) GRID_BAR(); }
    if (IN(1)) { pg8::Gemm g{XN, (const bf16*)(ws + WS_W_IN), MR, N_AB, DM}; pg8::StaticOrder S; S.init(MR, N_AB, F.G, (int)blockIdx.x);
        pg8::EpiQKV0 E{QKV, args.out, (bf16*)(ws + WS_KAS), (bf16*)(ws + WS_VAS), (bf16*)(ws + WS_KBS), (bf16*)(ws + WS_VBS)};
        pg8::gemm_phase<pg8::EpiQKV0, pg8::StaticOrder, PG8_ALIGN, PG8_SP2>(ring, g, S, E); if (BOTH(1)) GRID_BAR(); }
    if (IN(2)) { naive_attn0(F, args); if (BOTH(2)) GRID_BAR(); }
    if (IN(3)) { pg8::Gemm g{ATT, (const bf16*)(ws + WS_W_OUTAB), MR, DM, DM}; pg8::StaticOrder S; S.init(MR, DM, F.G, (int)blockIdx.x);
        pg8::EpiResid E{args.in[0], args.in[1], H};
        pg8::gemm_phase<pg8::EpiResid, pg8::StaticOrder, PG8_ALIGN, PG8_SP2>(ring, g, S, E); if (BOTH(3)) GRID_BAR(); }
    if (IN(4)) { rms_phase(F, H, args.in[9], XN); if (BOTH(4)) GRID_BAR(); }
    if (IN(5)) { pg8::Gemm g{XN, (const bf16*)(ws + WS_W_GU0), MR, N_GU, DM}; pg8::StaticOrder S; S.init(MR, N_GU, F.G, (int)blockIdx.x);
        pg8::EpiSwiGLU E{ACT};
        pg8::gemm_phase<pg8::EpiSwiGLU, pg8::StaticOrder, PG8_ALIGN, PG8_SP2>(ring, g, S, E); if (BOTH(5)) GRID_BAR(); }
    if (IN(6)) { pg8::Gemm g{ACT, (const bf16*)(ws + WS_W_DN0), MR, DM, DFF}; pg8::StaticOrder S; S.init(MR, DM, F.G, (int)blockIdx.x);
        pg8::EpiResid E{H, H + (size_t)NPR * DM, H};
        pg8::gemm_phase<pg8::EpiResid, pg8::StaticOrder, PG8_ALIGN, PG8_SP2>(ring, g, S, E); if (BOTH(6)) GRID_BAR(); }
    if (IN(7)) { rms_phase(F, H, args.in[8] + DM, XN); if (BOTH(7)) GRID_BAR(); }
    if (IN(8)) { pg8::Gemm g{XN, (const bf16*)(ws + WS_W_QKVC), MR, N_C, DM}; pg8::StaticOrder S; S.init(MR, N_C, F.G, (int)blockIdx.x);
        pg8::EpiQKV1 E{QKV, args.out, (bf16*)(ws + WS_KCS), (bf16*)(ws + WS_VCS), (const float*)(ws + WS_ROPE)};
        pg8::gemm_phase<pg8::EpiQKV1, pg8::StaticOrder, PG8_ALIGN, PG8_SP2>(ring, g, S, E); if (BOTH(8)) GRID_BAR(); }
    if (IN(9)) { naive_attn1(F, args); if (BOTH(9)) GRID_BAR(); }
    if (IN(10)) { pg8::Gemm g{ATT, (const bf16*)(ws + WS_W_OUTC), MR, DM, DM}; pg8::StaticOrder S; S.init(MR, DM, F.G, (int)blockIdx.x);
        pg8::EpiResid E{H, H + (size_t)NPR * DM, H};
        pg8::gemm_phase<pg8::EpiResid, pg8::StaticOrder, PG8_ALIGN, PG8_SP2>(ring, g, S, E); if (BOTH(10)) GRID_BAR(); }
    if (IN(11)) { rms_phase(F, H, args.in[9] + DM, XN); if (BOTH(11)) GRID_BAR(); }
    if (IN(12)) { pg8::Gemm g{XN, (const bf16*)(ws + WS_W_GU1), MR, N_GU, DM}; pg8::StaticOrder S; S.init(MR, N_GU, F.G, (int)blockIdx.x);
        pg8::EpiSwiGLU E{ACT};
        pg8::gemm_phase<pg8::EpiSwiGLU, pg8::StaticOrder, PG8_ALIGN, PG8_SP2>(ring, g, S, E); if (BOTH(12)) GRID_BAR(); }
    if (IN(13)) { pg8::Gemm g{ACT, (const bf16*)(ws + WS_W_DN1), MR, DM, DFF}; pg8::StaticOrder S; S.init(MR, DM, F.G, (int)blockIdx.x);
        pg8::EpiResid E{H, H + (size_t)NPR * DM, H};
        pg8::gemm_phase<pg8::EpiResid, pg8::StaticOrder, PG8_ALIGN, PG8_SP2>(ring, g, S, E); if (BOTH(13)) GRID_BAR(); }
    if (IN(14)) { const int gw = F.vcu * NWAVES + F.wave, NGW = F.G * NWAVES;
        for (int m = gw; m < MR; m += NGW) rms_row<true>(H + (size_t)m * DM, args.in[10], args.out + (size_t)m * DM, F.lane); }
#undef IN
#undef BOTH
}

extern "C" void kernel_launch(void* const* d_in, const int* in_sizes, int n_in, void* d_out, int out_size, void* d_ws, size_t ws_size, hipStream_t stream) {
    static int grid = 0;
    if (grid == 0) {
        if (n_in != 20 || in_sizes[0] != NPR * DM || (size_t)out_size != O_END || ws_size < WS_END) { fprintf(stderr, "kernel_launch: unexpected shapes (n_in %d, in0 %d, out %d, ws %zu); nothing launched\n", n_in, n_in > 0 ? in_sizes[0] : -1, out_size, ws_size); grid = -1; return; }
        int dev = 0, cus = 0, per_cu = 0;
        if (hipGetDevice(&dev) != hipSuccess || hipDeviceGetAttribute(&cus, hipDeviceAttributeMultiprocessorCount, dev) != hipSuccess) { fprintf(stderr, "kernel_launch: device query failed\n"); grid = -1; return; }
        if (hipFuncSetAttribute((const void*)fwd, hipFuncAttributeMaxDynamicSharedMemorySize, LDS_BYTES) != hipSuccess) { fprintf(stderr, "kernel_launch: hipFuncSetAttribute failed\n"); grid = -1; return; }
        if (hipOccupancyMaxActiveBlocksPerMultiprocessor(&per_cu, (const void*)fwd, NWAVES * 64, LDS_BYTES) != hipSuccess || per_cu < 1) { fprintf(stderr, "kernel_launch: occupancy query says %d blocks per CU\n", per_cu); }
        (void)hipGetLastError();
        grid = cus;
    }
    if (grid < 0) return;
    if (hipMemsetAsync((char*)d_ws + WS_CTL, 0, CTL_ZERO_BYTES, stream) != hipSuccess) { fprintf(stderr, "kernel_launch: memset failed\n"); return; }
    Args a{};
    for (int i = 0; i < 20; ++i) a.in[i] = (const float*)d_in[i];
    a.out = (float*)d_out; a.ws = (unsigned char*)d_ws;
#if MK_PER_PHASE
    for (int li = 0; li < N_PHASES; ++li) { a.ph_lo = li; a.ph_hi = li + 1; hipLaunchKernelGGL(fwd, dim3(grid), dim3(NWAVES * 64), LDS_BYTES, stream, a); }
#else
    a.ph_lo = 0; a.ph_hi = N_PHASES; hipLaunchKernelGGL(fwd, dim3(grid), dim3(NWAVES * 64), LDS_BYTES, stream, a);
#endif
    const hipError_t le = hipPeekAtLastError();
    if (le != hipSuccess) fprintf(stderr, "kernel_launch: launch failed: %s\n", hipGetErrorName(le));
}
```

```cpp
#include <hip/hip_runtime.h>
#include <cstdio>
#include <cstdint>
namespace pg8 {
#define PG8_LAS __attribute__((address_space(3)))
typedef unsigned short bf16_t;
typedef short bf16x8 __attribute__((ext_vector_type(8)));
typedef float f32x4 __attribute__((ext_vector_type(4)));
typedef unsigned u32x4 __attribute__((ext_vector_type(4)));
constexpr int BM = 256, BK = 64, HALF = 128, HTB = HALF * BK * 2  , STAGE_BYTES = 8 * HTB, NXCD = 8, WGM = 4;

__host__ __device__ __forceinline__ int lds_byte(int r, int c) { const int st = (r >> 4) * 2 + (c >> 5), rr = r & 15, cc = c & 31, ob = rr * 64 + cc * 2; return st * 1024 + (ob ^ (((ob >> 9) & 1) << 5)); }
__host__ __device__ __forceinline__ void stage_rc(int b, int& R, int& C) { const int st = b / 1024, sb = b % 1024, swz = sb ^ (((sb >> 9) & 1) << 5); R = (st >> 1) * 16 + swz / 64; C = (st & 1) * 32 + (swz % 64) / 2; }
__host__ __device__ __forceinline__ int perm32(int rho) { const int n = rho >> 4, i = rho & 15; return 8 * (i >> 2) + 4 * n + (i & 3); }

struct Unit { int pm, pn, kt0, nt, s; };
struct Gemm { const bf16_t* A; const bf16_t* Bt; int M, N, K; };

struct StaticOrder {
    int nM, nN, nwg, G, c, ntk;
    __host__ __device__ void init(int M, int N, int G_, int c_) { nM = M / BM; nN = N / BM; nwg = nM * nN; G = G_; c = c_; }
    __host__ __device__ __forceinline__ bool next(int i, Unit& u) const {
        const long L0 = (long)i * G + c; const bool ok = L0 < nwg; const long L = ok ? L0 : 0;
        int wgid = (int)L; { const int q = nwg / NXCD, r = nwg % NXCD, xcd = wgid % NXCD, off = wgid / NXCD; wgid = (xcd < r ? xcd * (q + 1) : r * (q + 1) + (xcd - r) * q) + off; }
        const int nig = WGM * nN, gid = wgid / nig, fm = gid * WGM, gsz = (nM - fm) < WGM ? (nM - fm) : WGM;
        u.pm = fm + ((wgid % nig) % gsz); u.pn = (wgid % nig) / gsz; u.kt0 = 0; u.nt = ntk; u.s = -1; return ok;
    }
    __device__ __forceinline__ void a_ready(const Unit&) const {}
    __device__ __forceinline__ void done(const Unit&) const {}
};

__device__ __forceinline__ unsigned cvt_pk_bf16(float lo, float hi) { unsigned r; asm volatile("v_cvt_pk_bf16_f32 %0, %1, %2" : "=v"(r) : "v"(lo), "v"(hi)); return r; }
typedef float f32x2 __attribute__((ext_vector_type(2)));

struct SplitTailOrder {
    StaticOrder base; int nfull, nitems, nN, pm0, ntk;
    __host__ __device__ void init(int M0, int M, int N, int K, int G_, int c_) { base.init(M0, N, G_, c_); base.ntk = K / BK; ntk = K / BK; nfull = base.nwg; nN = N / BM; pm0 = M0 / BM; nitems = (M - M0) / BM * nN * 8; }
    __host__ __device__ __forceinline__ bool next(int i, Unit& u) const {
        const bool ifirst = (nitems % base.G) == 0;
        const int nir = nitems / base.G, nfr = (nfull + base.G - 1) / base.G;
        const bool full = ifirst ? i >= nir : i < nfr;
        Unit a; const bool oka = base.next(full ? (ifirst ? i - nir : i) : 0, a);
        long jl = (long)(ifirst ? i : i - nfr) * base.G + base.c; const bool okb = !full && jl >= 0 && jl < nitems; const int j = okb ? (int)jl : 0;
        const int s = j & 7, t = j >> 3;
        const int q = (ntk / 16) * 2, r = (ntk - 8 * q) / 2;
        u.pm = full ? a.pm : pm0 + t / nN; u.pn = full ? a.pn : t % nN; u.s = full ? -1 : s;
        u.nt = full ? ntk : q + (s < r ? 2 : 0); u.kt0 = full ? 0 : s * q + 2 * (s < r ? s : r);
        return full ? oka : okb;
    }
    __device__ __forceinline__ void a_ready(const Unit&) const {}
    __device__ __forceinline__ void done(const Unit&) const {}
};
template <class Epi, class Sched, bool ALIGN_EPI = false, bool SP2 = false>
__device__ __forceinline__ void gemm_phase(PG8_LAS unsigned char* lds, const Gemm g, const Sched& S, const Epi& E, const int wid, const int lane) {
    const int tid = wid * 64 + lane, wr = wid >> 2, wc = wid & 3, fr = lane & 15, fq = lane >> 4;
    const int K = g.K;
    unsigned voffA[2], voffB[2];
#pragma unroll
    for (int i = 0; i < 2; ++i) { int R, C; stage_rc(tid * 16 + i * 8192, R, C); const int Rb = Epi::PERM ? ((R & ~31) + perm32(R & 31)) : R;
        voffA[i] = (unsigned)(R * K + C) * 2u; voffB[i] = (unsigned)(Rb * K + C) * 2u; }
    const size_t kstep = (size_t)(BK * 2);
    const size_t hstep = (size_t)HALF * K * 2;
    const size_t tstep = 2 * hstep;
    const unsigned ldsw = (unsigned)wid * 1024u;
    const int aoff = lds_byte(wr * 64 + fr, fq * 8), boff = lds_byte(wc * 32 + fr, fq * 8);
#define PG8_SA(b, h) (((b) * 2 + (h)) * HTB)
#define PG8_SB(b, h) ((4 + (b) * 2 + (h)) * HTB)
#define PG8_STAGE(bufoff, gbase, voff) do { _Pragma("unroll") for (int _i = 0; _i < 2; ++_i) \
        __builtin_amdgcn_global_load_lds((const unsigned*)((const char*)(gbase) + (voff)[_i]), (PG8_LAS unsigned*)(lds + (bufoff) + ldsw + _i * 8192), 16, 0, 0); } while (0)
#define PG8_LDA(dst, b, h) do { _Pragma("unroll") for (int m = 0; m < 4; ++m) _Pragma("unroll") for (int k = 0; k < 2; ++k) dst[m][k] = *(const PG8_LAS bf16x8*)(lds + PG8_SA(b, h) + aoff + m * 2048 + k * 1024); } while (0)
#define PG8_LDB(dst, b, h) do { _Pragma("unroll") for (int n = 0; n < 2; ++n) _Pragma("unroll") for (int k = 0; k < 2; ++k) dst[n][k] = *(const PG8_LAS bf16x8*)(lds + PG8_SB(b, h) + boff + n * 2048 + k * 1024); } while (0)
#define PG8_MMA(ai, bj, At, Bt) do { __builtin_amdgcn_s_setprio(1); _Pragma("unroll") for (int m = 0; m < 4; ++m) _Pragma("unroll") for (int n = 0; n < 2; ++n) _Pragma("unroll") for (int k = 0; k < 2; ++k) \
        acc[ai][bj][m][n] = __builtin_amdgcn_mfma_f32_16x16x32_bf16(Bt[n][k], At[m][k], acc[ai][bj][m][n], 0, 0, 0); __builtin_amdgcn_s_setprio(0); } while (0)
#define PG8_WAIT_V(n) asm volatile("s_waitcnt vmcnt(" #n ")" ::: "memory")
#define PG8_WAIT_L(n) asm volatile("s_waitcnt lgkmcnt(" #n ")" ::: "memory")
#define PG8_BAR __builtin_amdgcn_s_barrier()
#define PG8_SCHED __builtin_amdgcn_sched_barrier(0)
    Unit cur, nxt; int ui = 0;
    if (!S.next(0, cur)) return;
    f32x4 acc[2][2][4][2];
#pragma unroll
    for (int a = 0; a < 2; ++a)
#pragma unroll
        for (int b = 0; b < 2; ++b)
#pragma unroll
            for (int m = 0; m < 4; ++m)
#pragma unroll
                for (int n = 0; n < 2; ++n) acc[a][b][m][n] = (f32x4){0.f, 0.f, 0.f, 0.f};
    bf16x8 At[4][2], B0[2][2], B1[2][2];
    const char* cA = (const char*)g.A + (size_t)cur.pm * tstep + (size_t)cur.kt0 * kstep; const char* cB = (const char*)g.Bt + (size_t)cur.pn * tstep + (size_t)cur.kt0 * kstep;
    S.a_ready(cur);
    if constexpr (SP2) {
        PG8_STAGE(PG8_SB(0, 0), cB, voffB); PG8_STAGE(PG8_SB(0, 1), cB + hstep, voffB); PG8_STAGE(PG8_SA(0, 0), cA, voffA); PG8_STAGE(PG8_SA(0, 1), cA + hstep, voffA);
        if (wr == 1) PG8_BAR;
        PG8_WAIT_V(2); PG8_BAR;
        PG8_STAGE(PG8_SB(1, 0), cB + kstep, voffB); PG8_STAGE(PG8_SA(1, 0), cA + kstep, voffA); PG8_STAGE(PG8_SB(1, 1), cB + hstep + kstep, voffB);
        PG8_WAIT_V(6); PG8_BAR;
    } else {
        PG8_STAGE(PG8_SB(0, 0), cB, voffB); PG8_STAGE(PG8_SA(0, 0), cA, voffA); PG8_STAGE(PG8_SB(0, 1), cB + hstep, voffB); PG8_STAGE(PG8_SA(0, 1), cA + hstep, voffA);
        if (wr == 1) PG8_BAR;
        PG8_WAIT_V(4); PG8_BAR;
        PG8_STAGE(PG8_SB(1, 0), cB + kstep, voffB); PG8_STAGE(PG8_SA(1, 0), cA + kstep, voffA); PG8_STAGE(PG8_SB(1, 1), cB + hstep + kstep, voffB);
        PG8_WAIT_V(6); PG8_BAR;
    }
    for (;;) {
        const bool has_next = S.next(ui + 1, nxt);
        const char* nA = has_next ? (const char*)g.A + (size_t)nxt.pm * tstep + (size_t)nxt.kt0 * kstep : cA; const char* nB = has_next ? (const char*)g.Bt + (size_t)nxt.pn * tstep + (size_t)nxt.kt0 * kstep : cB;
        const int nt = cur.nt;
        for (int t = 0; t < nt; t += 2) {
            const bool last = (t == nt - 2);
            const char* a1 = cA + (size_t)(t + 1) * kstep;
            const char* a2 = last ? nA : cA + (size_t)(t + 2) * kstep; const char* b2 = last ? nB : cB + (size_t)(t + 2) * kstep;
            const char* a3 = a2 + kstep; const char* b3 = b2 + kstep;
            if (last && has_next) S.a_ready(nxt);
            if constexpr (SP2) {
            PG8_LDB(B0, 0, 0); PG8_LDB(B1, 0, 1); PG8_SCHED; PG8_LDA(At, 0, 0); PG8_STAGE(PG8_SA(1, 1), a1 + hstep, voffA);
            PG8_WAIT_V(8); PG8_WAIT_L(0); PG8_BAR; PG8_MMA(0, 0, At, B0); PG8_MMA(0, 1, At, B1); PG8_BAR; PG8_SCHED;
            PG8_LDA(At, 0, 1); PG8_STAGE(PG8_SB(0, 0), b2, voffB); PG8_STAGE(PG8_SB(0, 1), b2 + hstep, voffB); PG8_STAGE(PG8_SA(0, 0), a2, voffA);
            PG8_WAIT_V(8); PG8_WAIT_L(0); PG8_BAR; PG8_MMA(1, 0, At, B0); PG8_MMA(1, 1, At, B1); PG8_BAR; PG8_SCHED;
            PG8_LDB(B0, 1, 0); PG8_LDB(B1, 1, 1); PG8_SCHED; PG8_LDA(At, 1, 0); PG8_STAGE(PG8_SA(0, 1), a2 + hstep, voffA);
            PG8_WAIT_V(8); PG8_WAIT_L(0); PG8_BAR; PG8_MMA(0, 0, At, B0); PG8_MMA(0, 1, At, B1); PG8_BAR; PG8_SCHED;
            PG8_LDA(At, 1, 1); PG8_STAGE(PG8_SB(1, 0), b3, voffB); PG8_STAGE(PG8_SB(1, 1), b3 + hstep, voffB); PG8_STAGE(PG8_SA(1, 0), a3, voffA);
            PG8_WAIT_V(8); PG8_WAIT_L(0); PG8_BAR; PG8_MMA(1, 0, At, B0); PG8_MMA(1, 1, At, B1); PG8_BAR; PG8_SCHED;
            } else {
            PG8_LDB(B0, 0, 0); PG8_SCHED; PG8_LDA(At, 0, 0); PG8_STAGE(PG8_SA(1, 1), a1 + hstep, voffA);
            PG8_WAIT_L(8); PG8_BAR; PG8_WAIT_L(0); PG8_MMA(0, 0, At, B0); PG8_BAR; PG8_SCHED;
            PG8_LDB(B1, 0, 1); PG8_STAGE(PG8_SB(0, 0), b2, voffB);
            PG8_BAR; PG8_WAIT_L(0); PG8_MMA(0, 1, At, B1); PG8_BAR;
            PG8_LDA(At, 0, 1); PG8_STAGE(PG8_SA(0, 0), a2, voffA);
            PG8_BAR; PG8_WAIT_L(0); PG8_MMA(1, 0, At, B0); PG8_BAR; PG8_SCHED;
            PG8_STAGE(PG8_SB(0, 1), b2 + hstep, voffB);
            PG8_WAIT_V(6); PG8_BAR; PG8_MMA(1, 1, At, B1); PG8_BAR;
            PG8_LDB(B0, 1, 0); PG8_SCHED; PG8_LDA(At, 1, 0); PG8_STAGE(PG8_SA(0, 1), a2 + hstep, voffA);
            PG8_WAIT_L(8); PG8_BAR; PG8_WAIT_L(0); PG8_MMA(0, 0, At, B0); PG8_BAR; PG8_SCHED;
            PG8_LDB(B1, 1, 1); PG8_STAGE(PG8_SB(1, 0), b3, voffB);
            PG8_BAR; PG8_WAIT_L(0); PG8_MMA(0, 1, At, B1); PG8_BAR;
            PG8_LDA(At, 1, 1); PG8_STAGE(PG8_SA(1, 0), a3, voffA);
            PG8_BAR; PG8_WAIT_L(0); PG8_MMA(1, 0, At, B0); PG8_BAR; PG8_SCHED;
            PG8_STAGE(PG8_SB(1, 1), b3 + hstep, voffB);
            PG8_WAIT_V(6); PG8_BAR; PG8_MMA(1, 1, At, B1); PG8_BAR;
            }
        }
        if constexpr (ALIGN_EPI) { if (wr == 0) PG8_BAR; }
        if constexpr (!Epi::AFTER_DRAIN) { E(acc, cur, wr, wc, fr, fq); S.done(cur); }
        if (!has_next) break;
#pragma unroll
        for (int a = 0; a < 2; ++a)
#pragma unroll
            for (int b = 0; b < 2; ++b)
#pragma unroll
                for (int m = 0; m < 4; ++m)
#pragma unroll
                    for (int n = 0; n < 2; ++n) acc[a][b][m][n] = (f32x4){0.f, 0.f, 0.f, 0.f};
        cur = nxt; cA = nA; cB = nB; ++ui;
        if constexpr (ALIGN_EPI) { if (wr == 1) PG8_BAR; }
    }
    PG8_WAIT_V(0);
    if constexpr (!ALIGN_EPI) { if (wr == 0) PG8_BAR; }
    PG8_BAR;
    if constexpr (Epi::AFTER_DRAIN) { E.fused(acc, cur, wr, wc, fr, fq, lds, wid, lane); S.done(cur); }
#undef PG8_SA
#undef PG8_SB
#undef PG8_STAGE
#undef PG8_LDA
#undef PG8_LDB
#undef PG8_MMA
#undef PG8_WAIT_V
#undef PG8_WAIT_L
#undef PG8_BAR
#undef PG8_SCHED
}
}
constexpr int DM = 4096, SEQ = 2048, BP = 4, BS = 16, TS = 32, PAST = 1024;
constexpr int NPR = BP * SEQ, NSR = BS * TS, MR = NPR + NSR;
constexpr int DFF = 11008, N_AB = 12288, N_C = 5120, N_GU = 2 * DFF;
constexpr int W_AB = 2048;
constexpr int LA_S = PAST + TS, LB_S = 512 + TS, LC_S = 128 + TS;
constexpr float RMS_EPS = 1e-6f;
constexpr size_t O_Y_P = 0, O_Y_S = O_Y_P + (size_t)NPR * DM, O_SBK_P = O_Y_S + (size_t)NSR * DM, O_SBV_P = O_SBK_P + (size_t)NPR * W_AB,
                 O_BK_P = O_SBV_P + (size_t)NPR * W_AB, O_BV_P = O_BK_P + (size_t)BP * 512 * W_AB, O_CK_P = O_BV_P + (size_t)BP * 512 * W_AB, O_CV_P = O_CK_P + (size_t)BP * 128 * 512,
                 O_SBK_S = O_CV_P + (size_t)BP * 128 * 512, O_SBV_S = O_SBK_S + (size_t)NSR * W_AB, O_BK_S = O_SBV_S + (size_t)NSR * W_AB, O_BV_S = O_BK_S + (size_t)BS * 512 * W_AB,
                 O_CK_S = O_BV_S + (size_t)BS * 512 * W_AB, O_CV_S = O_CK_S + (size_t)BS * 128 * 512, O_END = O_CV_S + (size_t)BS * 128 * 512;
static_assert(O_END == 115867648, "output size");

namespace pg8 {
__device__ __forceinline__ u32x4 pack8(const f32x4& a, const f32x4& b) { u32x4 w; w.x = cvt_pk_bf16(a[0], a[1]); w.y = cvt_pk_bf16(a[2], a[3]); w.z = cvt_pk_bf16(b[0], b[1]); w.w = cvt_pk_bf16(b[2], b[3]); return w; }

struct EpiQKV0 {
    static constexpr bool PERM = true, AFTER_DRAIN = false;
    bf16_t* QKV; float* out; bf16_t *kAs, *vAs, *kBs, *vBs;
    __device__ __forceinline__ void operator()(const f32x4 (&acc)[2][2][4][2], const Unit& u, int wr, int wc, int fr, int fq) const {
        const int seg = u.pn >> 3, cs0 = (u.pn & 7) * 256 + wc * 32 + 8 * fq;
        const bool sample = u.pm >= 32;
        const bool isk = (seg == 1 || seg == 4), isv = (seg == 2 || seg == 5), isb = seg >= 3;
        float* fb = nullptr; bf16_t* sb = nullptr; int f_bs = 0, f_off = 0, s_len = 0, s_off = 0;
        if (isk || isv) {
            if (!sample) {
                if (!isb) fb = out + (isk ? O_SBK_P : O_SBV_P) + (size_t)(u.pm * 256) * W_AB;
                else if ((u.pm & 7) >= 6) fb = out + (isk ? O_BK_P : O_BV_P) + (size_t)((u.pm >> 3) * 512 + (u.pm & 7) * 256 - 1536) * W_AB;
            } else {
                if (!isb) { fb = out + (isk ? O_SBK_S : O_SBV_S); f_bs = TS; f_off = 0; sb = isk ? kAs : vAs; s_len = LA_S; s_off = PAST; }
                else      { fb = out + (isk ? O_BK_S : O_BV_S); f_bs = 512; f_off = 512 - TS; sb = isk ? kBs : vBs; s_len = LB_S; s_off = 512; }
            }
        }
#pragma unroll
        for (int ai = 0; ai < 2; ++ai)
#pragma unroll
            for (int m = 0; m < 4; ++m) {
                const int rl = ai * HALF + wr * 64 + m * 16 + fr; const size_t row = (size_t)u.pm * BM + rl;
                size_t frow = rl, srow = 0;
                if (sample) { const int r2 = (u.pm - 32) * 256 + rl, bs = r2 >> 5, t = r2 & 31; frow = (size_t)bs * f_bs + f_off + t; srow = (size_t)bs * s_len + s_off + t; }
#pragma unroll
                for (int bj = 0; bj < 2; ++bj) {
                    const int cs = cs0 + bj * HALF; const f32x4 v0 = acc[ai][bj][m][0], v1 = acc[ai][bj][m][1]; const u32x4 w = pack8(v0, v1);
                    *(u32x4*)(QKV + row * N_AB + seg * W_AB + cs) = w;
                    if (fb) { float* f = fb + frow * W_AB + cs; *(f32x4*)f = v0; *(f32x4*)(f + 4) = v1; }
                    if (sb) *(u32x4*)(sb + srow * W_AB + cs) = w;
                }
            }
    }
};
struct EpiQKV1 {
    static constexpr bool PERM = true, AFTER_DRAIN = false;
    bf16_t* QKV; float* out; bf16_t *kCs, *vCs; const float* rope;
    __device__ __forceinline__ void operator()(const f32x4 (&acc)[2][2][4][2], const Unit& u, int wr, int wc, int fr, int fq) const {
        const bool sample = u.pm >= 32; const int typ = u.pn < 16 ? 0 : (u.pn < 18 ? 1 : 2);
        const bool do_rope = (typ < 2) && ((wc & 1) == 0);
        const int cq0 = u.pn * 256 + wc * 32 + 8 * fq, ck0 = (u.pn & 1) * 256 + wc * 32 + 8 * fq;
        float* fb = nullptr; bf16_t* sb = nullptr;
        if (typ) { if (sample) { fb = out + (typ == 1 ? O_CK_S : O_CV_S); sb = typ == 1 ? kCs : vCs; } else if ((u.pm & 7) == 7) fb = out + (typ == 1 ? O_CK_P : O_CV_P) + (size_t)((u.pm >> 3) * 128) * 512; }
#pragma unroll
        for (int ai = 0; ai < 2; ++ai)
#pragma unroll
            for (int m = 0; m < 4; ++m) {
                const int rl = ai * HALF + wr * 64 + m * 16 + fr; const size_t row = (size_t)u.pm * BM + rl;
                int pos, bs = 0, t = 0; if (sample) { const int r2 = (u.pm - 32) * 256 + rl; bs = r2 >> 5; t = r2 & 31; pos = PAST + t; } else pos = (u.pm & 7) * 256 + rl;
                f32x4 cs0v, cs1v, sn0v, sn1v;
                if (do_rope) { const f32x4* rp = (const f32x4*)(rope + (size_t)pos * 16); cs0v = rp[0]; cs1v = rp[1]; sn0v = rp[2]; sn1v = rp[3]; if (fq == 0) { sn0v = -sn0v; sn1v = -sn1v; } }
#pragma unroll
                for (int bj = 0; bj < 2; ++bj) {
                    f32x4 v0 = acc[ai][bj][m][0], v1 = acc[ai][bj][m][1];
                    if (do_rope) {
                        f32x4 p0, p1;
#pragma unroll
                        for (int j = 0; j < 4; ++j) { p0[j] = __shfl_xor(v0[j], 16); p1[j] = __shfl_xor(v1[j], 16); }
                        if (fq < 2) { v0 = v0 * cs0v + p0 * sn0v; v1 = v1 * cs1v + p1 * sn1v; }
                    }
                    const u32x4 w = pack8(v0, v1);
                    if (typ == 0 || !sample) *(u32x4*)(QKV + row * N_C + cq0 + bj * HALF) = w;
                    if (typ) {
                        const int cs = ck0 + bj * HALF;
                        if (sample) { float* f = fb + ((size_t)bs * 128 + (128 - TS) + t) * 512 + cs; *(f32x4*)f = v0; *(f32x4*)(f + 4) = v1; *(u32x4*)(sb + ((size_t)bs * LC_S + 128 + t) * 512 + cs) = w; }
                        else if (fb && ai == 1) { float* f = fb + (size_t)(rl - 128) * 512 + cs; *(f32x4*)f = v0; *(f32x4*)(f + 4) = v1; }
                    }
                }
            }
    }
};
template <bool SRC_F32>
struct EpiResid {
    static constexpr bool PERM = true, AFTER_DRAIN = false;
    const void* rp; bf16_t* H; bf16_t* P;
    __device__ __forceinline__ void operator()(const f32x4 (&acc)[2][2][4][2], const Unit& u, int wr, int wc, int fr, int fq) const {
        const int col0 = u.pn * BM + wc * 32 + 8 * fq;
        const size_t row00 = (size_t)u.pm * BM + wr * 64 + fr;
        if (u.s >= 0) {
#pragma unroll
            for (int ai = 0; ai < 2; ++ai)
#pragma unroll
                for (int m = 0; m < 4; ++m) { bf16_t* dst = P + ((size_t)u.s * NSR + (row00 + ai * HALF + m * 16 - NPR)) * DM + col0;
#pragma unroll
                    for (int bj = 0; bj < 2; ++bj) *(u32x4*)(dst + bj * HALF) = pack8(acc[ai][bj][m][0], acc[ai][bj][m][1]); }
        } else if constexpr (SRC_F32) {
#pragma unroll
            for (int ai = 0; ai < 2; ++ai) { f32x4 ra[4][2][2];
#pragma unroll
                for (int m = 0; m < 4; ++m)
#pragma unroll
                    for (int bj = 0; bj < 2; ++bj) { const float* s = (const float*)rp + (row00 + ai * HALF + m * 16) * DM + col0 + bj * HALF; ra[m][bj][0] = *(const f32x4*)s; ra[m][bj][1] = *(const f32x4*)(s + 4); }
                asm volatile("" ::: "memory");
#pragma unroll
                for (int m = 0; m < 4; ++m)
#pragma unroll
                    for (int bj = 0; bj < 2; ++bj) *(u32x4*)(H + (row00 + ai * HALF + m * 16) * DM + col0 + bj * HALF) = pack8(ra[m][bj][0] + acc[ai][bj][m][0], ra[m][bj][1] + acc[ai][bj][m][1]);
                asm volatile("" ::: "memory"); }
        } else {
            u32x4 rv[2][4][2];
#pragma unroll
            for (int ai = 0; ai < 2; ++ai)
#pragma unroll
                for (int m = 0; m < 4; ++m)
#pragma unroll
                    for (int bj = 0; bj < 2; ++bj) rv[ai][m][bj] = *(const u32x4*)((const bf16_t*)rp + (row00 + ai * HALF + m * 16) * DM + col0 + bj * HALF);
            asm volatile("" ::: "memory");
#pragma unroll
            for (int ai = 0; ai < 2; ++ai)
#pragma unroll
                for (int m = 0; m < 4; ++m)
#pragma unroll
                    for (int bj = 0; bj < 2; ++bj) { const u32x4 w = rv[ai][m][bj]; const unsigned w0 = w[0], w1 = w[1], w2 = w[2], w3 = w[3]; f32x4 a, b;
                        a[0] = __builtin_bit_cast(float, w0 << 16); a[1] = __builtin_bit_cast(float, w0 & 0xffff0000u); a[2] = __builtin_bit_cast(float, w1 << 16); a[3] = __builtin_bit_cast(float, w1 & 0xffff0000u);
                        b[0] = __builtin_bit_cast(float, w2 << 16); b[1] = __builtin_bit_cast(float, w2 & 0xffff0000u); b[2] = __builtin_bit_cast(float, w3 << 16); b[3] = __builtin_bit_cast(float, w3 & 0xffff0000u);
                        *(u32x4*)(H + (row00 + ai * HALF + m * 16) * DM + col0 + bj * HALF) = pack8(a + acc[ai][bj][m][0], b + acc[ai][bj][m][1]); }
        }
    }
};
struct EpiSwiGLU {
    static constexpr bool PERM = true, AFTER_DRAIN = false;
    bf16_t* ACT;
    __device__ __forceinline__ void operator()(const f32x4 (&acc)[2][2][4][2], const Unit& u, int wr, int wc, int fr, int fq) const {
        const int col0 = u.pn * HALF + wc * 32 + 8 * fq;
#pragma unroll
        for (int ai = 0; ai < 2; ++ai)
#pragma unroll
            for (int m = 0; m < 4; ++m) {
                const size_t row = (size_t)u.pm * BM + ai * HALF + wr * 64 + m * 16 + fr;
                f32x4 r[2];
#pragma unroll
                for (int n = 0; n < 2; ++n)
#pragma unroll
                    for (int j = 0; j < 4; ++j) { const float g = acc[ai][0][m][n][j], up = acc[ai][1][m][n][j]; r[n][j] = g * __builtin_amdgcn_rcpf(1.0f + __builtin_amdgcn_exp2f(-1.4426950408889634f * g)) * up; }
                *(u32x4*)(ACT + row * DFF + col0) = pack8(r[0], r[1]);
            }
    }
};
}
#define PG8_SP2 true
#define PG8_ALIGN true
constexpr int NWAVES = 8;
constexpr int N_PHASES = 15;
#ifndef MK_PER_PHASE
#define MK_PER_PHASE 0
#endif
constexpr size_t MiB = 1u << 20;
constexpr size_t WS_CTL = 0, CTL_ZERO_BYTES = 1 * MiB;
constexpr size_t WS_ROPE = 1 * MiB;
constexpr size_t WS_W_IN = 2 * MiB, WS_W_OUTAB = 98 * MiB, WS_W_QKVC = 130 * MiB, WS_W_OUTC = 170 * MiB;
constexpr size_t WS_W_GU0 = 202 * MiB, WS_W_GU1 = 374 * MiB, WS_W_DN0 = 546 * MiB, WS_W_DN1 = 632 * MiB;
constexpr size_t WS_H = 718 * MiB;
constexpr size_t WS_XN = 854 * MiB;
constexpr size_t WS_QKV = 922 * MiB;
constexpr size_t WS_ATT = 1126 * MiB;
constexpr size_t WS_ACT = 1194 * MiB;
constexpr size_t WS_KAS = 1377 * MiB, WS_VAS = 1443 * MiB, WS_KBS = 1509 * MiB, WS_VBS = 1543 * MiB, WS_KCS = 1577 * MiB, WS_VCS = 1580 * MiB;
constexpr size_t WS_P = 1583 * MiB;
constexpr size_t WS_END = 1647 * MiB;
static_assert(WS_W_IN + (size_t)N_AB * DM * 2 <= WS_W_OUTAB && WS_W_OUTAB + (size_t)DM * DM * 2 <= WS_W_QKVC && WS_W_QKVC + (size_t)N_C * DM * 2 <= WS_W_OUTC && WS_W_OUTC + (size_t)DM * DM * 2 <= WS_W_GU0, "ws map 1");
static_assert(WS_W_GU0 + (size_t)N_GU * DM * 2 <= WS_W_GU1 && WS_W_GU1 + (size_t)N_GU * DM * 2 <= WS_W_DN0 && WS_W_DN0 + (size_t)DM * DFF * 2 <= WS_W_DN1 && WS_W_DN1 + (size_t)DM * DFF * 2 <= WS_H, "ws map 2");
static_assert(WS_H + (size_t)MR * DM * 4 <= WS_XN && WS_XN + (size_t)MR * DM * 2 <= WS_QKV && WS_QKV + (size_t)MR * N_AB * 2 <= WS_ATT && WS_ATT + (size_t)MR * DM * 2 <= WS_ACT && WS_ACT + (size_t)MR * DFF * 2 <= WS_KAS, "ws map 3");
static_assert(WS_KAS + (size_t)BS * LA_S * W_AB * 2 <= WS_VAS && WS_VAS + (size_t)BS * LA_S * W_AB * 2 <= WS_KBS && WS_KBS + (size_t)BS * LB_S * W_AB * 2 <= WS_VBS && WS_VBS + (size_t)BS * LB_S * W_AB * 2 <= WS_KCS &&
              WS_KCS + (size_t)BS * LC_S * 512 * 2 <= WS_VCS && WS_VCS + (size_t)BS * LC_S * 512 * 2 <= WS_P && WS_P + (size_t)8 * NSR * DM * 4 <= WS_END, "ws map 4");
#ifndef CV_PRO_END_DEF
#define CV_PRO_END_DEF CV_L0
#endif
constexpr int CW_BAR = 4096;
constexpr int RING_OFF = 0, RING_BYTES = 131072;
constexpr int LDSCTL_OFF = RING_BYTES, MISC_OFF = LDSCTL_OFF + 320;
constexpr int LDS_BYTES = 147456;
static_assert(MISC_OFF + 128 <= LDS_BYTES, "LDS map");
#define GAS __attribute__((address_space(1)))
#define LAS __attribute__((address_space(3)))
typedef unsigned short bf16;
typedef unsigned v4u __attribute__((ext_vector_type(4)));
typedef float f32x4 __attribute__((ext_vector_type(4)));
typedef short bf16x8 __attribute__((ext_vector_type(8)));
typedef GAS unsigned gu32;
typedef GAS unsigned long long gu64;
#define RLX_AGENT __ATOMIC_RELAXED, __HIP_MEMORY_SCOPE_AGENT
#define LDS_WAIT() asm volatile("s_waitcnt lgkmcnt(0)" ::: "memory")
#define VM_WAIT() asm volatile("s_waitcnt vmcnt(0)" ::: "memory")
__device__ __forceinline__ unsigned long long rt() { return __builtin_amdgcn_s_memrealtime(); }
__device__ __forceinline__ unsigned f2bf(float f) { unsigned u = __builtin_bit_cast(unsigned, f); return (u + 0x7fffu + ((u >> 16) & 1u)) >> 16; }
__device__ __forceinline__ unsigned pk2(float lo, float hi) { return f2bf(lo) | (f2bf(hi) << 16); }

#define XB_TMO      128
#define XB_XCNT(j)  (256  + 64 * (j))
#define XB_XSUB(j)  (1280 + 64 * (j))
#define XB_XGEN(j)  (2304 + 64 * (j))
#define XB_TOP      3328
#define XB_TOPGEN   3392
#define XCD_BAR_WORDS 3456
#define XB_SPIN_CAP (1u << 18)

__device__ __forceinline__ unsigned xb_ld(unsigned* p)              { return __hip_atomic_load(p, __ATOMIC_RELAXED, __HIP_MEMORY_SCOPE_AGENT); }
__device__ __forceinline__ unsigned xb_add(unsigned* p, unsigned v) { return __hip_atomic_fetch_add(p, v, __ATOMIC_RELAXED, __HIP_MEMORY_SCOPE_AGENT); }
__device__ __forceinline__ unsigned xb_xcc_id() { return (unsigned)__builtin_amdgcn_s_getreg((3 << 11) | 20) & 0xFu; }
#define XB_SPIN(cond, bar) do { unsigned _sp = 0; while (cond) { __builtin_amdgcn_s_sleep(1); \
    if ((++_sp & 255u) == 0u) { if (xb_ld(&(bar)[XB_TMO])) break; if (_sp > XB_SPIN_CAP) { atomicAdd(&(bar)[XB_TMO], 1u); break; } } } } while (0)

struct XcdBarrier {
    unsigned* bar; unsigned x;
    volatile LAS unsigned* st;
};

__device__ __forceinline__ XcdBarrier xcd_barrier_post(unsigned* bar, volatile LAS unsigned* st) {
    XcdBarrier b; b.bar = bar; b.x = xb_xcc_id(); b.st = st;
    if (threadIdx.x == 0) (void)xb_add(&bar[XB_XCNT(b.x)], 1u);
    return b;
}
__device__ __forceinline__ void xcd_barrier_complete(unsigned* bar, unsigned x, unsigned& nloc, unsigned& nx) {
    const unsigned G = gridDim.x * gridDim.y * gridDim.z;
    unsigned sum, cnt, mine, sp = 0u;
    for (;;) {
        sum = 0u; cnt = 0u; mine = 0u;
#pragma unroll
        for (unsigned j = 0; j < 16; ++j) { const unsigned c = xb_ld(&bar[XB_XCNT(j)]); sum += c; cnt += (c > 0u) ? 1u : 0u; mine = (j == x) ? c : mine; }
        if (sum == G) break;
        __builtin_amdgcn_s_sleep(1);
        if ((++sp & 255u) == 0u) { if (xb_ld(&bar[XB_TMO])) break; if (sp > XB_SPIN_CAP) { atomicAdd(&bar[XB_TMO], 1u); break; } }
    }
    nloc = mine > 0u ? mine : 1u; nx = cnt > 0u ? cnt : 1u;
}

__device__ __forceinline__ void xcd_barrier(const XcdBarrier& b, const bool t0) {
    asm volatile("s_waitcnt vmcnt(0)" ::: "memory");
    __syncthreads();
    if (t0) {
        unsigned* bar = b.bar;
        __builtin_amdgcn_s_waitcnt(0);
        unsigned nloc = b.st[0], nx = b.st[1];
        if (nloc == 0u) { xcd_barrier_complete(bar, b.x, nloc, nx); b.st[0] = nloc; b.st[1] = nx; }
        const unsigned old = xb_add(&bar[XB_XSUB(b.x)], 1u);
        const unsigned gen = old / nloc;
        if (old + 1u == (gen + 1u) * nloc) {
            __builtin_amdgcn_fence(__ATOMIC_RELEASE, "agent");
            asm volatile("s_waitcnt vmcnt(0)" ::: "memory");
            const unsigned og = xb_add(&bar[XB_TOP], 1u);
            const unsigned tg = og / nx;
            if (og + 1u == (tg + 1u) * nx) xb_add(&bar[XB_TOPGEN], 1u);
            else XB_SPIN(xb_ld(&bar[XB_TOPGEN]) == tg, bar);
            __builtin_amdgcn_fence(__ATOMIC_ACQUIRE, "agent");
            xb_add(&bar[XB_XGEN(b.x)], 1u);
            asm volatile("s_waitcnt vmcnt(0)" ::: "memory");
        } else {
            XB_SPIN(xb_ld(&bar[XB_XGEN(b.x)]) == gen, bar);
            __builtin_amdgcn_fence(__ATOMIC_ACQUIRE, "agent");
            asm volatile("s_waitcnt vmcnt(0)" ::: "memory");
        }
    }
    __syncthreads();
}

struct Frame {
    LAS unsigned char* lds;
    volatile LAS unsigned* MISC;
    gu32* ctl;
    int wave;
    int vcu, G;
};
__device__ __forceinline__ int lane_now() { int l; asm volatile("v_mbcnt_lo_u32_b32 %0, -1, 0\n\tv_mbcnt_hi_u32_b32 %0, -1, %0" : "=v"(l)); return l; }
__device__ __forceinline__ float wave_sum(float v) {
#pragma unroll
    for (int o = 1; o < 64; o <<= 1) v += __shfl_xor(v, o);
    return v;
}
__device__ __forceinline__ float wave_max(float v) {
#pragma unroll
    for (int o = 1; o < 64; o <<= 1) v = fmaxf(v, __shfl_xor(v, o));
    return v;
}
__device__ __forceinline__ float bflo(unsigned w) { return __builtin_bit_cast(float, w << 16); }
__device__ __forceinline__ float bfhi(unsigned w) { return __builtin_bit_cast(float, w & 0xffff0000u); }

typedef short v4i16p __attribute__((ext_vector_type(4)));
struct TrItem { const float* src; bf16* dst; int N, K; };
__device__ __forceinline__ void p0_tr_load(f32x4 (&v)[16], const TrItem& t, int lane) {
    const float* src = t.src + (size_t)(lane >> 4) * t.N + 4 * (lane & 15);
#pragma unroll
    for (int i = 0; i < 16; ++i) v[i] = __builtin_nontemporal_load((const f32x4*)(src + (size_t)(4 * i) * t.N));
}
__device__ __forceinline__ void p0_tr_store(const f32x4 (&v)[16], const TrItem& t, LAS unsigned char* img, int lane) {
#pragma unroll
    for (int i = 0; i < 16; ++i) { typedef unsigned u32x2t __attribute__((ext_vector_type(2))); u32x2t w; w.x = pk2(v[i].x, v[i].y); w.y = pk2(v[i].z, v[i].w); *(LAS u32x2t*)(img + 192 * (4 * i + (lane >> 4)) + 8 * (lane & 15)) = w; }
    LDS_WAIT(); asm volatile("" ::: "memory");
    const int g = lane >> 4, i16 = lane & 15, q = i16 >> 2, p = i16 & 3;
#pragma unroll
    for (int a = 0; a < 4; ++a)
#pragma unroll
        for (int j = 0; j < 2; ++j) { const int kc = 4 * j + g; const unsigned ad = (unsigned)(size_t)img + 192 * (8 * kc + q) + 32 * a + 8 * p;
            const v4i16p lo = __builtin_amdgcn_ds_read_tr16_b64_v4i16((LAS v4i16p*)(size_t)ad), hi = __builtin_amdgcn_ds_read_tr16_b64_v4i16((LAS v4i16p*)(size_t)(ad + 4 * 192));
            const bf16x8 o = __builtin_shufflevector(lo, hi, 0, 1, 2, 3, 4, 5, 6, 7);
            *(bf16x8*)(t.dst + (size_t)(16 * a + i16) * t.K + 8 * kc) = o; }
    LDS_WAIT(); asm volatile("" ::: "memory");
}
template <bool OUT_F32>
__device__ __forceinline__ void rms_row(const float* xrow, const float* g, void* orow, int lane, float osc = 1.0f, const float* slabs = nullptr, float* hrow = nullptr) {
    f32x4 v[16]; float s = 0.f;
#pragma unroll
    for (int j = 0; j < 8; ++j) { const f32x4* p = (const f32x4*)(xrow + j * 512 + lane * 8); v[2 * j] = p[0]; v[2 * j + 1] = p[1]; }
    if (slabs) {
#pragma unroll 1
        for (int sl = 0; sl < 8; ++sl) { const float* ps = slabs + (size_t)sl * NSR * DM;
#pragma unroll
            for (int j = 0; j < 8; ++j) { const f32x4* p = (const f32x4*)(ps + j * 512 + lane * 8); v[2 * j] += p[0]; v[2 * j + 1] += p[1]; } }
        if (hrow) {
#pragma unroll
            for (int j = 0; j < 8; ++j) { f32x4* p = (f32x4*)(hrow + j * 512 + lane * 8); p[0] = v[2 * j]; p[1] = v[2 * j + 1]; } }
    }
#pragma unroll
    for (int j = 0; j < 16; ++j) s += (v[j].x * v[j].x + v[j].y * v[j].y) + (v[j].z * v[j].z + v[j].w * v[j].w);
    const float r = osc / sqrtf(wave_sum(s) * (1.0f / DM) + RMS_EPS);
#pragma unroll
    for (int j = 0; j < 8; ++j) { const f32x4* gp = (const f32x4*)(g + j * 512 + lane * 8); const f32x4 a = v[2 * j] * r * gp[0], b = v[2 * j + 1] * r * gp[1];
        if (OUT_F32) { f32x4* o = (f32x4*)((float*)orow + j * 512 + lane * 8); o[0] = a; o[1] = b; }
        else { v4u w; w.x = pk2(a.x, a.y); w.y = pk2(a.z, a.w); w.z = pk2(b.x, b.y); w.w = pk2(b.z, b.w); *(v4u*)((bf16*)orow + j * 512 + lane * 8) = w; } }
}
__device__ __forceinline__ v4u cvt8(const float* p) { const f32x4 a = *(const f32x4*)p, b = *(const f32x4*)(p + 4); v4u w; w.x = pk2(a.x, a.y); w.y = pk2(a.z, a.w); w.z = pk2(b.x, b.y); w.w = pk2(b.z, b.w); return w; }

template <bool OUT_F32>
__device__ __forceinline__ void rms_row_b(const bf16* xrow, const float* g, void* orow, int lane) {
    f32x4 v[16]; float s = 0.f;
#pragma unroll
    for (int j = 0; j < 8; ++j) { const v4u w = *(const v4u*)(xrow + j * 512 + lane * 8); const unsigned w0 = w.x, w1 = w.y, w2 = w.z, w3 = w.w;
        v[2 * j].x = __builtin_bit_cast(float, w0 << 16); v[2 * j].y = __builtin_bit_cast(float, w0 & 0xffff0000u); v[2 * j].z = __builtin_bit_cast(float, w1 << 16); v[2 * j].w = __builtin_bit_cast(float, w1 & 0xffff0000u);
        v[2 * j + 1].x = __builtin_bit_cast(float, w2 << 16); v[2 * j + 1].y = __builtin_bit_cast(float, w2 & 0xffff0000u); v[2 * j + 1].z = __builtin_bit_cast(float, w3 << 16); v[2 * j + 1].w = __builtin_bit_cast(float, w3 & 0xffff0000u); }
#pragma unroll
    for (int j = 0; j < 16; ++j) s += (v[j].x * v[j].x + v[j].y * v[j].y) + (v[j].z * v[j].z + v[j].w * v[j].w);
    const float r = 1.0f / sqrtf(wave_sum(s) * (1.0f / DM) + RMS_EPS);
#pragma unroll
    for (int j = 0; j < 8; ++j) { const f32x4* gp = (const f32x4*)(g + j * 512 + lane * 8); const f32x4 a = v[2 * j] * r * gp[0], b = v[2 * j + 1] * r * gp[1];
        if (OUT_F32) { f32x4* o = (f32x4*)((float*)orow + j * 512 + lane * 8); o[0] = a; o[1] = b; }
        else { v4u w; w.x = pk2(a.x, a.y); w.y = pk2(a.z, a.w); w.z = pk2(b.x, b.y); w.w = pk2(b.z, b.w); *(v4u*)((bf16*)orow + j * 512 + lane * 8) = w; } }
}

struct Args { const float* in[20]; float* out; unsigned char* ws; int ph_lo, ph_hi; };
static_assert(sizeof(Args) == 22 * 8 + 8, "Args has no padding");

constexpr int CV_IN = 64 * (N_AB / 64), CV_O = 64 * (DM / 64), CV_QC = 64 * (N_C / 64), CV_G = 64 * (DFF / 64), CV_D = (DFF / 64) * (DM / 64);
constexpr int CV_L0 = CV_IN + CV_O + 2 * CV_G + CV_D, CV_L1 = CV_QC + CV_O + 2 * CV_G + CV_D, CV_ALL = CV_L0 + CV_L1;
#ifndef CVR_D1_N
#define CVR_D1_N 21000
#endif
#ifndef CVR_D2_N
#define CVR_D2_N 20000
#endif
#ifndef CVR_D3_N
#define CVR_D3_N 13000
#endif
constexpr int CVR_A_END = CV_IN + CV_O + 2 * CV_G, CVR_B_END = CV_ALL - CV_D;
constexpr int CVR_D1_END = (CV_IN + CVR_D1_N) < CVR_A_END ? (CV_IN + CVR_D1_N) : CVR_A_END;
constexpr int CVR_D2_END = (CVR_A_END + CVR_D2_N) < CVR_B_END ? (CVR_A_END + CVR_D2_N) : CVR_B_END;
constexpr int CVR_D3_END = (CVR_D2_END + CVR_D3_N) < CVR_B_END ? (CVR_D2_END + CVR_D3_N) : CVR_B_END;
static_assert(CVR_D2_END >= CV_L0 + CV_QC, "w_qkv_c must be converted before the layer-1 QKV GEMM");
__device__ __forceinline__ void cv_decode(const Args& A, int it, TrItem& t) {
    unsigned char* ws = A.ws;
    int r = it; const int l = r >= CV_L0; if (l) r -= CV_L0;
    const float* W; bf16* WT; int K = DM, N; int mode = 0;
    const int c_first = l ? CV_QC : CV_IN;
    if (r < c_first) { W = l ? A.in[14] : A.in[11]; WT = (bf16*)(ws + (l ? WS_W_QKVC : WS_W_IN)); N = l ? N_C : N_AB; }
    else if ((r -= c_first) < CV_O) { W = l ? A.in[15] : A.in[12]; WT = (bf16*)(ws + (l ? WS_W_OUTC : WS_W_OUTAB)); N = DM; }
    else if ((r -= CV_O) < CV_G) { W = A.in[17] + (size_t)l * DM * DFF; WT = (bf16*)(ws + (l ? WS_W_GU1 : WS_W_GU0)); N = DFF; mode = 1; }
    else if ((r -= CV_G) < CV_G) { W = A.in[18] + (size_t)l * DM * DFF; WT = (bf16*)(ws + (l ? WS_W_GU1 : WS_W_GU0)); N = DFF; mode = 2; }
    else { r -= CV_G; W = A.in[19] + (size_t)l * DFF * DM; WT = (bf16*)(ws + (l ? WS_W_DN1 : WS_W_DN0)); N = DM; K = DFF; }
    const int nblk = N / 64, kb = r / nblk, nb = r % nblk, n0 = 64 * nb;
    const int drow0 = mode == 0 ? n0 : (256 * (n0 >> 7) + (n0 & 127) + (mode == 2 ? 128 : 0));
    t.src = W + (size_t)(64 * kb) * N + n0; t.dst = WT + (size_t)drow0 * K + 64 * kb; t.N = N; t.K = K;
}
__device__ __forceinline__ int cv_pro_item(int v) { constexpr int n0 = CV_IN, n1 = CVR_A_END - CVR_D1_END; return v < n0 ? v : (v < n0 + n1 ? CVR_D1_END + (v - n0) : CVR_D3_END + (v - n0 - n1)); }
constexpr int CV_PRO_N = CV_IN + (CVR_A_END - CVR_D1_END) + (CVR_B_END - CVR_D3_END);
template <bool PRO = false>
__device__ __forceinline__ void convert_range(Frame& F, const Args& A, int it0, int it1, int worker, int nworkers, int lane) {
    LAS unsigned char* scr = F.lds + RING_OFF + F.wave * 12288;
    f32x4 va[16], vb[16]; TrItem ta, tb; int it = it0 + worker;
    if (it < it1) { cv_decode(A, PRO ? cv_pro_item(it) : it, ta); p0_tr_load(va, ta, lane); }
    while (it < it1) {
        const int itb = it + nworkers; const bool hb = itb < it1;
        if (hb) { cv_decode(A, PRO ? cv_pro_item(itb) : itb, tb); p0_tr_load(vb, tb, lane); }
        p0_tr_store(va, ta, scr, lane);
        if (!hb) break;
        it = itb + nworkers; const bool ha = it < it1;
        if (ha) { cv_decode(A, PRO ? cv_pro_item(it) : it, ta); p0_tr_load(va, ta, lane); }
        p0_tr_store(vb, tb, scr, lane);
        if (!ha) break;
    }
}
__device__ __forceinline__ void p0_prologue(Frame& F, const Args& A) {
    const int lane = lane_now(), tid = F.wave * 64 + lane;
    unsigned char* ws = A.ws;
    LAS unsigned char* scr = F.lds + RING_OFF + F.wave * 12288;
    const int gw = F.vcu * NWAVES + F.wave, NGW = F.G * NWAVES;
    constexpr int I_IN = 64 * (N_AB / 64), I_O = 64 * (DM / 64), I_QC = 64 * (N_C / 64), I_G = 64 * (DFF / 64), I_D = (DFF / 64) * (DM / 64);
    constexpr int NITEMS = I_IN + 2 * I_O + I_QC + 4 * I_G + 2 * I_D;
    convert_range<true>(F, A, 0, CV_PRO_N, gw, NGW, lane);
    const size_t gt = (size_t)F.vcu * (NWAVES * 64) + tid, NGT = (size_t)F.G * (NWAVES * 64);
    for (int kv = 0; kv < 2; ++kv) {
        const float* cB = A.in[4 + kv]; bf16* dB = (bf16*)(ws + (kv ? WS_VBS : WS_KBS)); float* oB = A.out + (kv ? O_BV_S : O_BK_S);
        for (size_t i = gt; i < (size_t)BS * 512 * W_AB / 8; i += NGT) { const size_t e = i * 8, bs = e / ((size_t)512 * W_AB), rem = e % ((size_t)512 * W_AB); const size_t rr = rem / W_AB;
            *(v4u*)(dB + bs * LB_S * W_AB + rem) = cvt8(cB + e);
            if (rr >= TS) { float* o = oB + e - (size_t)TS * W_AB; *(f32x4*)o = *(const f32x4*)(cB + e); *(f32x4*)(o + 4) = *(const f32x4*)(cB + e + 4); } }
        const float* cC = A.in[6 + kv]; bf16* dC = (bf16*)(ws + (kv ? WS_VCS : WS_KCS)); float* oC = A.out + (kv ? O_CV_S : O_CK_S);
        for (size_t i = gt; i < (size_t)BS * 128 * 512 / 8; i += NGT) { const size_t e = i * 8, bs = e / ((size_t)128 * 512), rem = e % ((size_t)128 * 512); const size_t rr = rem / 512;
            *(v4u*)(dC + bs * LC_S * 512 + rem) = cvt8(cC + e);
            if (rr >= TS) { float* o = oC + e - (size_t)TS * 512; *(f32x4*)o = *(const f32x4*)(cC + e); *(f32x4*)(o + 4) = *(const f32x4*)(cC + e + 4); } }
    }
    { float* rope = (float*)(ws + WS_ROPE);
      for (size_t i = gt; i < (size_t)SEQ * 8; i += NGT) { const int pos = (int)(i >> 3), fi = (int)(i & 7); const float inv = powf(500000.0f, -(float)fi / 8.0f); const float ang = (float)pos * inv;
          rope[pos * 16 + fi] = (float)cos((double)ang); rope[pos * 16 + 8 + fi] = (float)sin((double)ang); } }
    for (int m = gw; m < MR; m += NGW) rms_row<false>(m < NPR ? A.in[0] + (size_t)m * DM : A.in[1] + (size_t)(m - NPR) * DM, A.in[8], (bf16*)(ws + WS_XN) + (size_t)m * DM, lane);
}
template <bool OUT_F32>
__device__ __forceinline__ void rms_sample_rows(Frame& F, const float* sbase, const bf16* P, const float* g, float* Hout, void* out, float osc, int lane) {
    LAS float* red = (LAS float*)(F.lds + RING_OFF);
    const int col = F.wave * 512 + lane * 8;
    for (int r = F.vcu; r < NSR; r += F.G) {
        const float* b = sbase + (size_t)r * DM + col; f32x4 a0 = *(const f32x4*)b, a1 = *(const f32x4*)(b + 4);
#pragma unroll
        for (int s = 0; s < 8; ++s) { const v4u w = *(const v4u*)(P + ((size_t)s * NSR + r) * DM + col); const unsigned w0 = w.x, w1 = w.y, w2 = w.z, w3 = w.w;
            a0.x += bflo(w0); a0.y += bfhi(w0); a0.z += bflo(w1); a0.w += bfhi(w1); a1.x += bflo(w2); a1.y += bfhi(w2); a1.z += bflo(w3); a1.w += bfhi(w3); }
        if (Hout) { float* h = Hout + (size_t)r * DM + col; *(f32x4*)h = a0; *(f32x4*)(h + 4) = a1; }
        const float ss = wave_sum((a0.x * a0.x + a0.y * a0.y) + (a0.z * a0.z + a0.w * a0.w) + (a1.x * a1.x + a1.y * a1.y) + (a1.z * a1.z + a1.w * a1.w));
        if (lane == 0) red[F.wave] = ss;
        __syncthreads();
        float tot = 0.f;
#pragma unroll
        for (int w = 0; w < NWAVES; ++w) tot += red[w];
        const float rs = osc / sqrtf(tot * (1.0f / DM) + RMS_EPS);
        const f32x4 g0 = *(const f32x4*)(g + col), g1 = *(const f32x4*)(g + col + 4); const f32x4 y0 = a0 * rs * g0, y1 = a1 * rs * g1;
        if (OUT_F32) { float* o = (float*)out + (size_t)r * DM + col; *(f32x4*)o = y0; *(f32x4*)(o + 4) = y1; }
        else { v4u w; w.x = pk2(y0.x, y0.y); w.y = pk2(y0.z, y0.w); w.z = pk2(y1.x, y1.y); w.w = pk2(y1.z, y1.w); *(v4u*)((bf16*)out + (size_t)r * DM + col) = w; }
        __syncthreads();
    }
}
__device__ __forceinline__ void rms_phase(Frame& F, const bf16* Hb, float* Hs, const float* sbase, const bf16* P, const float* g, bf16* XN) {
    const int lane = lane_now();
    const int gw = F.vcu * NWAVES + F.wave, NGW = F.G * NWAVES;
    rms_sample_rows<false>(F, sbase, P, g, Hs, XN + (size_t)NPR * DM, 1.0f, lane);
    for (int m = gw; m < NPR; m += NGW) rms_row_b<false>(Hb + (size_t)m * DM, g, XN + (size_t)m * DM, lane);
}
namespace att {
typedef float f32x16 __attribute__((ext_vector_type(16)));
typedef unsigned u32x4 __attribute__((ext_vector_type(4)));
typedef short s16x4 __attribute__((ext_vector_type(4)));
typedef short v4i16_t __attribute__((ext_vector_type(4)));
typedef float f32x2_t __attribute__((ext_vector_type(2))); typedef __bf16 bf16x2_t __attribute__((ext_vector_type(2)));
__device__ __forceinline__ unsigned cvtpk(float lo, float hi) { f32x2_t v = {lo, hi}; bf16x2_t b = __builtin_convertvector(v, bf16x2_t); return __builtin_bit_cast(unsigned, b); }
__device__ __forceinline__ s16x4 vtr(unsigned a) { return __builtin_bit_cast(s16x4, __builtin_amdgcn_ds_read_tr16_b64_v4i16((LAS v4i16_t*)(size_t)a)); }
__device__ __forceinline__ float smul(float x, float a) { return x * a; }
__device__ __forceinline__ float ex2(float x) { return __builtin_amdgcn_exp2f(x); }
__device__ __forceinline__ float lg2(float x) { return __builtin_amdgcn_logf(x); }
__device__ __forceinline__ void swap_halves(float x, float& lo, float& hi) { const unsigned a = __builtin_bit_cast(unsigned, x), b = a;
    auto rr = __builtin_amdgcn_permlane32_swap(a, b, false, false); const unsigned r0 = rr[0], r1 = rr[1];
    lo = __builtin_bit_cast(float, r0); hi = __builtin_bit_cast(float, r1); }
__device__ __forceinline__ float both_max(float x) { float lo, hi; swap_halves(x, lo, hi); return fmaxf(lo, hi); }
__device__ __forceinline__ float both_sum(float x) { float lo, hi; swap_halves(x, lo, hi); return lo + hi; }
#define ATT_BAR() do { asm volatile("s_waitcnt vmcnt(0) lgkmcnt(0)" ::: "memory"); __builtin_amdgcn_s_barrier(); asm volatile("" ::: "memory"); } while (0)
#define ATT_BAR_TILE(more, N) do { if (more) asm volatile("s_waitcnt vmcnt(" #N ") lgkmcnt(0)" ::: "memory"); else asm volatile("s_waitcnt vmcnt(0) lgkmcnt(0)" ::: "memory"); __builtin_amdgcn_s_barrier(); asm volatile("" ::: "memory"); } while (0)
__device__ __forceinline__ int lane_fresh() { int l; asm volatile("v_mbcnt_lo_u32_b32 %0, -1, 0\n\tv_mbcnt_hi_u32_b32 %0, -1, %0" : "=v"(l)); return l; }
constexpr float LOG2E = 1.4426950408889634f;
constexpr int TILE_B128 = 16384, TILE_B64 = 8192;
constexpr int LDS_K0 = 0, LDS_V0 = 49152, LDS_TAB = 98304;
constexpr int ATT_LDS_BYTES = LDS_TAB + 2048;

template <int D> __device__ __forceinline__ void stage_tile(LAS unsigned char* lds, const bf16* k, const bf16* v, long stride, int jt, int nkeys, int slot, int wid, int lane, int slot_bytes = TILE_B128) {
    if (D == 128) {
#pragma unroll
        for (int i = 0; i < 2; ++i) { const int I = wid * 2 + i, row = 4 * I + (lane >> 4), cs = lane & 15, ch = cs ^ (((row & 3) << 2) | ((row >> 2) & 3));
            int j = jt * 64 + row; j = j < nkeys ? j : nkeys - 1; const long go = (long)j * stride + 8 * ch;
            __builtin_amdgcn_global_load_lds((const unsigned*)(k + go), (LAS unsigned*)(lds + LDS_K0 + slot * slot_bytes + I * 1024), 16, 0, 0);
            __builtin_amdgcn_global_load_lds((const unsigned*)(v + go), (LAS unsigned*)(lds + LDS_V0 + slot * slot_bytes + I * 1024), 16, 0, 0); }
    } else {
        const int I = wid, row = 8 * I + (lane >> 3), cs = lane & 7, ch = cs ^ (4 * ((row >> 1) & 1) + 2 * ((row >> 4) & 1) + ((row >> 3) & 1));
        int j = jt * 64 + row; j = j < nkeys ? j : nkeys - 1; const long go = (long)j * stride + 8 * ch;
        __builtin_amdgcn_global_load_lds((const unsigned*)(k + go), (LAS unsigned*)(lds + LDS_K0 + slot * slot_bytes + I * 1024), 16, 0, 0);
        __builtin_amdgcn_global_load_lds((const unsigned*)(v + go), (LAS unsigned*)(lds + LDS_V0 + slot * slot_bytes + I * 1024), 16, 0, 0);
    }
}
template <int D, int NQ> __device__ __forceinline__ void load_q(bf16x8 (&qf)[NQ][D / 16], const bf16* qw, long qstride, int lane) {
#pragma unroll
    for (int nq = 0; nq < NQ; ++nq)
#pragma unroll
        for (int s = 0; s < D / 16; ++s) qf[nq][s] = *(const bf16x8*)(qw + (long)(nq * 32 + (lane & 31)) * qstride + 16 * s + 8 * (lane >> 5));
}
template <int D, int NQ> __device__ __forceinline__ void qk_tile(f32x16 (&p)[NQ][2], const bf16x8 (&qf)[NQ][D / 16], unsigned kbuf, int lane) {
    const int r = lane & 31, h = lane >> 5;
    const unsigned kl = kbuf + (D == 128 ? 256 * r + 16 * (h ^ (((r & 3) << 2) | ((r >> 2) & 3))) : 128 * r + 16 * (h ^ (4 * ((r >> 1) & 1) + 2 * ((r >> 4) & 1) + ((r >> 3) & 1))));
    const float zero = 0.f;
#pragma unroll
    for (int nq = 0; nq < NQ; ++nq) { p[nq][0] = (f32x16)(zero); p[nq][1] = (f32x16)(zero); }
#pragma unroll
    for (int s = 0; s < D / 16; ++s)
#pragma unroll
        for (int kb2 = 0; kb2 < 2; ++kb2) { const bf16x8 a = *(const LAS bf16x8*)(size_t)((kl ^ (unsigned)(s << 5)) + (unsigned)(kb2 * 32 * D * 2));
#pragma unroll
            for (int nq = 0; nq < NQ; ++nq) p[nq][kb2] = __builtin_amdgcn_mfma_f32_32x32x16_bf16(a, qf[nq][s], p[nq][kb2], 0, 0, 0);
 }
}
template <int D, int NQ> __device__ __forceinline__ void pv_tile(f32x16 (&o)[NQ][D / 32], const bf16x8 (&pb)[NQ][4], unsigned vbuf, int lane) {
    const int h = lane >> 5, blk = (lane >> 4) & 1, q = (lane & 15) >> 2, pp = lane & 3, c2 = 2 * blk + (pp >> 1);
#pragma unroll
    for (int ks = 0; ks < 4; ++ks) {
        unsigned vl[2];
#pragma unroll
        for (int t = 0; t < 2; ++t) vl[t] = vbuf + (D == 128 ? 256 * (8 * t + 4 * h + q) + 16 * (4 * q + (c2 ^ (2 * t + h))) + 8 * (pp & 1) + 4096 * ks
                                                              : 128 * (8 * t + 4 * h + q) + 16 * (4 * ((q >> 1) & 1) + (c2 ^ (2 * (ks & 1) + t))) + 8 * (pp & 1) + 2048 * ks);
        s16x4 lo[D / 32], hi[D / 32];
#pragma unroll
        for (int db = 0; db < D / 32; ++db) { lo[db] = vtr(vl[0] ^ (unsigned)(db << 6)); hi[db] = vtr(vl[1] ^ (unsigned)(db << 6)); }
#pragma unroll
        for (int db = 0; db < D / 32; ++db) { const bf16x8 a = __builtin_shufflevector(lo[db], hi[db], 0, 1, 2, 3, 4, 5, 6, 7);
#pragma unroll
            for (int nq = 0; nq < NQ; ++nq) o[nq][db] = __builtin_amdgcn_mfma_f32_32x32x16_bf16(a, pb[nq][ks], o[nq][db], 0, 0, 0); }
        __builtin_amdgcn_sched_group_barrier(0x100, 2 * (D / 32), 0);
        __builtin_amdgcn_sched_group_barrier(0x008, NQ * (D / 32), 0);
    }
}
template <int D> __device__ __forceinline__ void pv_tile1(f32x16 (&o)[D / 32], const bf16x8 (&pb)[4], unsigned vbuf, int lane) {
    const int h = lane >> 5, blk = (lane >> 4) & 1, q = (lane & 15) >> 2, pp = lane & 3, c2 = 2 * blk + (pp >> 1);
#pragma unroll
    for (int ks = 0; ks < 4; ++ks) {
        unsigned vl[2];
#pragma unroll
        for (int t = 0; t < 2; ++t) vl[t] = vbuf + (D == 128 ? 256 * (8 * t + 4 * h + q) + 16 * (4 * q + (c2 ^ (2 * t + h))) + 8 * (pp & 1) + 4096 * ks
                                                              : 128 * (8 * t + 4 * h + q) + 16 * (4 * ((q >> 1) & 1) + (c2 ^ (2 * (ks & 1) + t))) + 8 * (pp & 1) + 2048 * ks);
#pragma unroll
        for (int db = 0; db < D / 32; ++db) { const s16x4 lo = vtr(vl[0] ^ (unsigned)(db << 6)), hi = vtr(vl[1] ^ (unsigned)(db << 6));
            const bf16x8 a = __builtin_shufflevector(lo, hi, 0, 1, 2, 3, 4, 5, 6, 7);
            o[db] = __builtin_amdgcn_mfma_f32_32x32x16_bf16(a, pb[ks], o[db], 0, 0, 0); }
    }
}
__device__ __forceinline__ void pack_p(bf16x8 (&pb)[4], const f32x16& p0, const f32x16& p1) {
#pragma unroll
    for (int s2 = 0; s2 < 2; ++s2) {
        u32x4 a, b;
#pragma unroll
        for (int j = 0; j < 4; ++j) { a[j] = cvtpk(p0[8 * s2 + 2 * j], p0[8 * s2 + 2 * j + 1]); b[j] = cvtpk(p1[8 * s2 + 2 * j], p1[8 * s2 + 2 * j + 1]); }
        pb[s2] = __builtin_bit_cast(bf16x8, a); pb[2 + s2] = __builtin_bit_cast(bf16x8, b);
    }
}
template <int D, int NQ> __device__ __forceinline__ void store_o(const f32x16 (&o)[NQ][D / 32], bf16* ow, long ostride, int nq_store, const float (&scale)[NQ], int lane) {
#pragma unroll
    for (int nq = 0; nq < NQ; ++nq) if (nq < nq_store) {
        bf16* orow = ow + (long)(nq * 32 + (lane & 31)) * ostride + 4 * (lane >> 5);
#pragma unroll
        for (int db = 0; db < D / 32; ++db)
#pragma unroll
            for (int g = 0; g < 4; ++g) { uint2 w; w.x = cvtpk(smul(o[nq][db][4 * g], scale[nq]), smul(o[nq][db][4 * g + 1], scale[nq])); w.y = cvtpk(smul(o[nq][db][4 * g + 2], scale[nq]), smul(o[nq][db][4 * g + 3], scale[nq]));
                *(uint2*)(orow + 32 * db + 8 * g) = w; }
    }
}

template <bool FULL> __device__ __forceinline__ void sb_block(f32x16& p, float& run, int lim, int h) {
    constexpr float C2 = 0.08838834764831845f * LOG2E;
    float r[16];
#pragma unroll
    for (int i = 0; i < 16; ++i) { const float u = ex2(fminf(p[i] * C2, 80.0f)); const float ri = __builtin_amdgcn_rcpf(1.0f + u); const float sg = u * ri;
        if (FULL) { p[i] = sg; r[i] = ri; }
        else { const bool ok = (8 * (i >> 2) + 4 * h + (i & 3)) < lim; p[i] = ok ? sg : 0.f; r[i] = ok ? ri : 1.0f; } }
#pragma unroll
    for (int u = 3; u >= 0; --u) {
        const float r32 = r[4 * u + 3] * r[4 * u + 2], gp = r32 * (r[4 * u + 1] * r[4 * u]);
        float a, b; swap_halves(gp, a, b);
        const float o1 = run; run *= b; const float o0 = run; run *= a;
        const float off = h ? o1 : o0;
        p[4 * u + 3] *= off; p[4 * u + 2] *= off * r[4 * u + 3]; p[4 * u + 1] *= off * r32; p[4 * u] *= off * (r32 * r[4 * u + 1]);
    }
}
template <bool BIAS> __device__ __forceinline__ float sm_tile(f32x16& p0, f32x16& p1, float& m, float& ls, float C2, const LAS float* tab, int dd0, int klim, int lane) {
    const int h = lane >> 5, dl = dd0 + (lane & 31);
    const bool cbias = BIAS && (dd0 - 63 >= 128);
    const float cb = BIAS ? tab[256] : 0.f;
    float mx = -INFINITY;
#pragma unroll
    for (int kb2 = 0; kb2 < 2; ++kb2) { f32x16& p = kb2 ? p1 : p0;
#pragma unroll
        for (int r = 0; r < 16; ++r) { const int key = 32 * kb2 + 8 * (r >> 2) + 4 * h + (r & 3); float s2 = p[r] * C2;
            if (BIAS) { if (cbias) s2 += cb; else { int d = dl - key; d = d > 128 ? 128 : d; s2 += tab[d + 128]; } }
            if (klim < 64 && key >= klim) s2 = -INFINITY;
            p[r] = s2; mx = fmaxf(mx, s2); } }
    mx = both_max(mx);
    const float mn = fmaxf(m, mx), alpha = ex2(m - mn); m = mn;
    float sum = 0.f;
#pragma unroll
    for (int r = 0; r < 16; ++r) { p0[r] = ex2(p0[r] - mn); p1[r] = ex2(p1[r] - mn); sum += p0[r] + p1[r]; }
    ls = ls * alpha + sum;
    return alpha;
}
template <int N> __device__ __forceinline__ void scale_o(f32x16 (&o)[N], float a) {
#pragma unroll
    for (int i = 0; i < N; ++i)
#pragma unroll
        for (int r = 0; r < 16; ++r) o[i][r] = smul(o[i][r], a);
}

struct UnitIO { const bf16* q; const bf16* k; const bf16* v; bf16* o; long qs, kvs, os; int nkeys; };

__device__ __forceinline__ void sb_unit(LAS unsigned char* lds, const UnitIO& U, int nrows, int qpos0, int kpos0, int wid, int lane) {
    const bool act = 32 * wid < nrows; const int qposw = qpos0 + 32 * wid;
    const int jlast = qpos0 + nrows - 2 - kpos0;
    const int t_hi = jlast >> 6;
    const int w_hi = act ? ((qposw + 30 - kpos0) >> 6) : -1;
    bf16x8 qf[1][8]; f32x16 o[1][4];
    if (act) load_q<128, 1>(qf, U.q + (long)(32 * wid) * U.qs, U.qs, lane);
#pragma unroll
    for (int i = 0; i < 4; ++i) o[0][i] = (f32x16)(0.f);
    float run = 1.0f;
    ATT_BAR();
    stage_tile<128>(lds, U.k, U.v, U.kvs, t_hi, U.nkeys, 0, wid, lane);
    if (t_hi > 0) stage_tile<128>(lds, U.k, U.v, U.kvs, t_hi - 1, U.nkeys, 1, wid, lane);
    for (int cur = 0, kt = t_hi; kt >= 0; cur = cur == 2 ? 0 : cur + 1, --kt) {
        ATT_BAR_TILE(kt > 0, 4);
        if (kt > 1) stage_tile<128>(lds, U.k, U.v, U.kvs, kt - 2, U.nkeys, cur == 0 ? 2 : cur - 1, wid, lane);
        if (kt <= w_hi) {
            f32x16 p[1][2]; bf16x8 pb[1][4];
            qk_tile<128, 1>(p, qf, (unsigned)(size_t)(lds + LDS_K0 + cur * TILE_B128), lane);
            const int dq = qposw - kpos0 - 64 * kt; const int lim = dq + (lane & 31);
            if (dq >= 64) { sb_block<true>(p[0][1], run, 0, lane >> 5); sb_block<true>(p[0][0], run, 0, lane >> 5); }
            else { sb_block<false>(p[0][1], run, lim - 32, lane >> 5); sb_block<false>(p[0][0], run, lim, lane >> 5); }
            pack_p(pb[0], p[0][0], p[0][1]);
            pv_tile<128, 1>(o, pb, (unsigned)(size_t)(lds + LDS_V0 + cur * TILE_B128), lane);
        }
    }
    const float one[1] = {1.0f};
    if (act) store_o<128, 1>(o, U.o + (long)(32 * wid) * U.os, U.os, 1, one, lane);
}
__device__ __forceinline__ void stg_load(f32x4 (&rk)[4][2], f32x4 (&rv)[4][2], bool f32src, const float* kc, const float* vc, long cstride, const bf16* kb, const bf16* vb, long bstride, int nkeys, int kt, int tix) {
#pragma unroll
    for (int i = 0; i < 4; ++i) { const int pi = 256 * i + tix, row = pi >> 4, ch = (pi & 15) ^ (((row & 3) << 2) | ((row >> 2) & 3));
        if (f32src) { const long go = (long)(kt * 64 + row) * cstride + 8 * ch;
            rk[i][0] = *(const f32x4*)(kc + go); rk[i][1] = *(const f32x4*)(kc + go + 4); rv[i][0] = *(const f32x4*)(vc + go); rv[i][1] = *(const f32x4*)(vc + go + 4); }
        else { int j = kt * 64 + row; j = j < nkeys ? j : nkeys - 1; const long go = (long)j * bstride + 8 * ch;
            rk[i][0] = __builtin_bit_cast(f32x4, *(const u32x4*)(kb + go)); rv[i][0] = __builtin_bit_cast(f32x4, *(const u32x4*)(vb + go)); rk[i][1] = rk[i][0]; rv[i][1] = rv[i][0]; } }
}
__device__ __forceinline__ void stg_write(const f32x4 (&rk)[4][2], const f32x4 (&rv)[4][2], bool f32src, LAS unsigned char* lds, int slot, int tix) {
#pragma unroll
    for (int i = 0; i < 4; ++i) { u32x4 wk, wv;
        if (f32src) { wk[0] = cvtpk(rk[i][0][0], rk[i][0][1]); wk[1] = cvtpk(rk[i][0][2], rk[i][0][3]); wk[2] = cvtpk(rk[i][1][0], rk[i][1][1]); wk[3] = cvtpk(rk[i][1][2], rk[i][1][3]);
                      wv[0] = cvtpk(rv[i][0][0], rv[i][0][1]); wv[1] = cvtpk(rv[i][0][2], rv[i][0][3]); wv[2] = cvtpk(rv[i][1][0], rv[i][1][1]); wv[3] = cvtpk(rv[i][1][2], rv[i][1][3]); }
        else { wk = __builtin_bit_cast(u32x4, rk[i][0]); wv = __builtin_bit_cast(u32x4, rv[i][0]); }
        *(LAS u32x4*)(lds + LDS_K0 + slot * TILE_B128 + (256 * i + tix) * 16) = wk; *(LAS u32x4*)(lds + LDS_V0 + slot * TILE_B128 + (256 * i + tix) * 16) = wv; }
}
__device__ __forceinline__ void sb_unit_f32cache(LAS unsigned char* lds, const UnitIO& U, const float* kc, const float* vc, long cstride, int ncache, int qpos0, int kpos0, int wid, int lane) {
    const int t_hi = (qpos0 + TS - 2 - kpos0) >> 6;
    ATT_BAR();
    lane = lane_fresh();
    if (wid >= 4) {
        const int tix = (wid - 4) * 64 + lane;
        f32x4 rk[4][2], rv[4][2];
#define load_regs(kt_) stg_load(rk, rv, (kt_) * 64 < ncache, kc, vc, cstride, U.k, U.v, U.kvs, U.nkeys, (kt_), tix)
#define write_regs(kt_, slot_) stg_write(rk, rv, (kt_) * 64 < ncache, lds, (slot_), tix)
        load_regs(t_hi); write_regs(t_hi, 0);
        if (t_hi > 0) load_regs(t_hi - 1);
#pragma unroll 1
        for (int cur = 0, kt = t_hi; kt >= 0; cur = cur == 2 ? 0 : cur + 1, --kt) {
            if (kt > 0) write_regs(kt - 1, cur == 2 ? 0 : cur + 1);
            ATT_BAR();
            if (kt > 1) load_regs(kt - 2);
        }
#undef load_regs
#undef write_regs
    } else {
        const bool act = wid == 0; const int w_hi = act ? ((qpos0 + 30 - kpos0) >> 6) : -1;
        bf16x8 qf[1][8]; f32x16 o[1][4];
        if (act) load_q<128, 1>(qf, U.q, U.qs, lane);
#pragma unroll
        for (int i = 0; i < 4; ++i) o[0][i] = (f32x16)(0.f);
        float run = 1.0f;
#pragma unroll 1
        for (int cur = 0, kt = t_hi; kt >= 0; cur = cur == 2 ? 0 : cur + 1, --kt) {
            ATT_BAR();
            if (kt <= w_hi) {
                f32x16 p[1][2]; bf16x8 pb[1][4];
                qk_tile<128, 1>(p, qf, (unsigned)(size_t)(lds + LDS_K0 + cur * TILE_B128), lane);
                const int dq = qpos0 - kpos0 - 64 * kt; const int lim = dq + (lane & 31);
                if (dq >= 64) { sb_block<true>(p[0][1], run, 0, lane >> 5); sb_block<true>(p[0][0], run, 0, lane >> 5); }
                else { sb_block<false>(p[0][1], run, lim - 32, lane >> 5); sb_block<false>(p[0][0], run, lim, lane >> 5); }
                pack_p(pb[0], p[0][0], p[0][1]);
                pv_tile<128, 1>(o, pb, (unsigned)(size_t)(lds + LDS_V0 + cur * TILE_B128), lane);
            }
        }
        const float one[1] = {1.0f};
        if (act) store_o<128, 1>(o, U.o, U.os, 1, one, lane);
    }
}
__device__ __forceinline__ void band_unit(LAS unsigned char* lds, const UnitIO& U, int nrows, int qpos0, int kc0, const float* bias_row, int tid, int wid, int lane) {
    constexpr float C2 = 0.08838834764831845f * LOG2E;
    const bool act = 32 * wid < nrows; const int qposw = qpos0 + 32 * wid, cw = qposw >> 6;
    const int tmax = (U.nkeys - 1) >> 6;
    const int c_lo = qpos0 >> 6, c_hi = (qpos0 + nrows - 1) >> 6;
    int t_lo = c_lo - 8 - kc0; t_lo = t_lo < 0 ? 0 : t_lo; int t_hi = c_hi - kc0; t_hi = t_hi > tmax ? tmax : t_hi;
    int w_lo = cw - 8 - kc0; w_lo = w_lo < 0 ? 0 : w_lo; int w_hi = cw - kc0; w_hi = w_hi > tmax ? tmax : w_hi; if (!act) { w_lo = 1; w_hi = 0; }
    LAS float* tab = (LAS float*)(lds + LDS_TAB);
    bf16x8 qf[1][8]; f32x16 o[1][4];
    if (act) load_q<128, 1>(qf, U.q + (long)(32 * wid) * U.qs, U.qs, lane);
#pragma unroll
    for (int i = 0; i < 4; ++i) o[0][i] = (f32x16)(0.f);
    float m = -INFINITY, ls = 0.f;
    ATT_BAR();
    if (tid < 257) tab[tid] = bias_row[tid] * LOG2E;
    stage_tile<128>(lds, U.k, U.v, U.kvs, t_hi, U.nkeys, 0, wid, lane);
    if (t_hi > t_lo) stage_tile<128>(lds, U.k, U.v, U.kvs, t_hi - 1, U.nkeys, 1, wid, lane);
    for (int cur = 0, kt = t_hi; kt >= t_lo; cur = cur == 2 ? 0 : cur + 1, --kt) {
        ATT_BAR_TILE(kt > t_lo, 4);
        if (kt > t_lo + 1) stage_tile<128>(lds, U.k, U.v, U.kvs, kt - 2, U.nkeys, cur == 0 ? 2 : cur - 1, wid, lane);
        if (kt >= w_lo && kt <= w_hi) {
            f32x16 p[1][2]; bf16x8 pb[1][4];
            qk_tile<128, 1>(p, qf, (unsigned)(size_t)(lds + LDS_K0 + cur * TILE_B128), lane);
            const int klim = U.nkeys - 64 * kt; const int dd0 = qposw - 64 * (kc0 + kt);
            const float alpha = sm_tile<true>(p[0][0], p[0][1], m, ls, C2, tab, dd0, klim < 64 ? klim : 64, lane);
            scale_o<4>(o[0], alpha);
            pack_p(pb[0], p[0][0], p[0][1]);
            pv_tile<128, 1>(o, pb, (unsigned)(size_t)(lds + LDS_V0 + cur * TILE_B128), lane);
        }
    }
    const float inv[1] = {1.0f / both_sum(ls)};
    if (act) store_o<128, 1>(o, U.o + (long)(32 * wid) * U.os, U.os, 1, inv, lane);
}
__device__ __forceinline__ void swa_stream(LAS unsigned char* lds, const UnitIO& U, int c0, int nch, const float* sinkp, int nblk, int wid, int lane) {
    constexpr float C2 = 0.125f * LOG2E;
    bf16x8 qf[2][4];
    const int tmin = c0 >= 2 ? c0 - 2 : 0;
    load_q<64, 2>(qf, U.q + 64 * wid, U.qs, lane_fresh());
    ATT_BAR();
#pragma unroll 1
    for (int t = tmin; t <= c0; ++t) stage_tile<64>(lds, U.k, U.v, U.kvs, t, U.nkeys, t & 3, wid, lane_fresh(), TILE_B64);
#pragma unroll 1
    for (int ci = 0; ci < nch; ++ci) {
        const int c = c0 + ci;
        ATT_BAR();
        if (ci + 1 < nch) stage_tile<64>(lds, U.k, U.v, U.kvs, c + 1, U.nkeys, (c + 1) & 3, wid, lane_fresh(), TILE_B64);
        f32x16 o[2][2];
#pragma unroll
        for (int a = 0; a < 2; ++a)
#pragma unroll
            for (int i = 0; i < 2; ++i) o[a][i] = (f32x16)(0.f);
        float m[2] = {-INFINITY, -INFINITY}, ls[2] = {0.f, 0.f};
        const int kt_lo = c >= 2 ? c - 2 : 0;
#pragma unroll 1
        for (int kt = c; kt >= kt_lo; --kt) {
            f32x16 p[2][2];
            qk_tile<64, 2>(p, qf, (unsigned)(size_t)(lds + LDS_K0 + (kt & 3) * TILE_B64), lane_fresh());
            const int klim = U.nkeys - 64 * kt;
#pragma unroll
            for (int nq = 0; nq < 2; ++nq) { bf16x8 pb[4]; const float alpha = sm_tile<false>(p[nq][0], p[nq][1], m[nq], ls[nq], C2, nullptr, 0, klim < 64 ? klim : 64, lane); scale_o<2>(o[nq], alpha); pack_p(pb, p[nq][0], p[nq][1]);
                pv_tile1<64>(o[nq], pb, (unsigned)(size_t)(lds + LDS_V0 + (kt & 3) * TILE_B64), lane_fresh()); __builtin_amdgcn_sched_barrier(0); }
        }
        if (ci + 1 < nch) load_q<64, 2>(qf, U.q + (long)(64 * (ci + 1)) * U.qs + 64 * wid, U.qs, lane_fresh());
        float inv[2];
#pragma unroll
        for (int nq = 0; nq < 2; ++nq) { const float l = both_sum(ls[nq]); inv[nq] = 1.0f / (l + ex2((*sinkp * LOG2E) - m[nq])); }
        store_o<64, 2>(o, U.o + (long)(64 * ci) * U.os + 64 * wid, U.os, nblk, inv, lane_fresh());
    }
}
}
__device__ __forceinline__ void attn0_phase(Frame& F, const Args& A) {
    unsigned char* ws = A.ws; const bf16* QKV = (const bf16*)(ws + WS_QKV); bf16* ATT = (bf16*)(ws + WS_ATT);
    LAS unsigned char* lds = F.lds + RING_OFF; const int lane = lane_now(), tid = F.wave * 64 + lane; (void)tid;
    { const int u = F.vcu;
        const int b = u >> 6, h = (u >> 2) & 15, pr = u & 3, bs = u >> 4, hs = u & 15;
#pragma unroll 1
        for (int e = 0; e < 2; ++e) {
            att::UnitIO U; const int qb = e ? pr : 7 - pr; const size_t row0 = (size_t)b * SEQ + 256 * qb; const bf16* kb = QKV + (size_t)b * SEQ * N_AB + h * 128;
            U.q = QKV + row0 * N_AB + h * 128; U.k = kb + W_AB; U.v = kb + 2 * W_AB; U.o = ATT + row0 * DM + h * 128; U.qs = N_AB; U.kvs = N_AB; U.os = DM; U.nkeys = SEQ;
            att::sb_unit(lds, U, 256, 256 * qb, 0, F.wave, lane);
        }
        {   att::UnitIO U; const size_t row0 = (size_t)NPR + bs * TS;
            U.q = QKV + row0 * N_AB + hs * 128; U.k = (const bf16*)(ws + WS_KAS) + (size_t)bs * LA_S * W_AB + hs * 128; U.v = (const bf16*)(ws + WS_VAS) + (size_t)bs * LA_S * W_AB + hs * 128;
            U.o = ATT + row0 * DM + hs * 128; U.qs = N_AB; U.kvs = W_AB; U.os = DM; U.nkeys = LA_S;
            att::sb_unit_f32cache(lds, U, A.in[2] + (size_t)bs * PAST * W_AB + hs * 128, A.in[3] + (size_t)bs * PAST * W_AB + hs * 128, W_AB, PAST, PAST, 0, F.wave, lane);
        }
#ifndef DUP_SUB
#define DUP_SUB 0
#endif
        for (int e2 = 0; e2 < 3 + (DUP_SUB == 2 ? 2 : 0) + (DUP_SUB == 4 ? 1 : 0); ++e2) { const int e = (DUP_SUB == 2 && e2 >= 3) ? e2 - 3 : ((DUP_SUB == 4 && e2 >= 3) ? 2 : e2);
            att::UnitIO U; int nrows, qpos0, kc0; const float* brow;
            if (e < 2) { const int qb = e ? pr : 7 - pr; const size_t row0 = (size_t)b * SEQ + 256 * qb; const bf16* kb = QKV + (size_t)b * SEQ * N_AB + h * 128;
                U.q = QKV + row0 * N_AB + 3 * W_AB + h * 128; U.k = kb + 4 * W_AB; U.v = kb + 5 * W_AB; U.o = ATT + row0 * DM + W_AB + h * 128; U.qs = N_AB; U.kvs = N_AB; U.os = DM; U.nkeys = SEQ;
                nrows = 256; qpos0 = 256 * qb; kc0 = 0; brow = A.in[13] + h * 257; }
            else { const size_t row0 = (size_t)NPR + bs * TS;
                U.q = QKV + row0 * N_AB + 3 * W_AB + hs * 128; U.k = (const bf16*)(ws + WS_KBS) + (size_t)bs * LB_S * W_AB + hs * 128; U.v = (const bf16*)(ws + WS_VBS) + (size_t)bs * LB_S * W_AB + hs * 128;
                U.o = ATT + row0 * DM + W_AB + hs * 128; U.qs = N_AB; U.kvs = W_AB; U.os = DM; U.nkeys = LB_S; nrows = TS; qpos0 = PAST; kc0 = (PAST - 512) / 64; brow = A.in[13] + hs * 257; }
            att::band_unit(lds, U, nrows, qpos0, kc0, brow, tid, F.wave, lane);
        }
    }
    ATT_BAR();
}
__device__ __forceinline__ void attn1_phase(Frame& F, const Args& A) {
    unsigned char* ws = A.ws; const bf16* QKV = (const bf16*)(ws + WS_QKV); bf16* ATT = (bf16*)(ws + WS_ATT);
    LAS unsigned char* lds = F.lds + RING_OFF; const int lane = lane_now();
    { const int w = F.vcu;
        for (int e = 0; e < 2; ++e) {
            att::UnitIO U; int c0, nch, nblk, kvh;
            if (e == 0) { const int b = w >> 6; kvh = (w >> 3) & 7; c0 = (w & 7) * 4; nch = 4; nblk = 2; const size_t row0 = (size_t)b * SEQ + 64 * c0; const bf16* kb = QKV + (size_t)b * SEQ * N_C + kvh * 64;
                U.q = QKV + row0 * N_C + kvh * 512; U.k = kb + 4096; U.v = kb + 4608; U.o = ATT + row0 * DM + kvh * 512; U.qs = N_C; U.kvs = N_C; U.os = DM; U.nkeys = SEQ; }
            else { if (w >= 128) break; const int bs = w >> 3; kvh = w & 7; const size_t row0 = (size_t)NPR + bs * TS; c0 = 2; nch = 1; nblk = 1;
                U.q = QKV + row0 * N_C + kvh * 512; U.k = (const bf16*)(ws + WS_KCS) + (size_t)bs * LC_S * 512 + kvh * 64; U.v = (const bf16*)(ws + WS_VCS) + (size_t)bs * LC_S * 512 + kvh * 64;
                U.o = ATT + row0 * DM + kvh * 512; U.qs = N_C; U.kvs = 512; U.os = DM; U.nkeys = LC_S; }
            att::swa_stream(lds, U, c0, nch, A.in[16] + kvh * 8 + F.wave, nblk, F.wave, lane);
        }
    }
    ATT_BAR();
}
__global__ void __launch_bounds__(NWAVES * 64, 2) fwd(Args args) {
    extern __shared__ __attribute__((aligned(16))) unsigned char lds[];
    Frame F;
    F.lds = (LAS unsigned char*)lds;
    F.MISC = (volatile LAS unsigned*)(F.lds + MISC_OFF);
    F.wave = __builtin_amdgcn_readfirstlane(threadIdx.x >> 6);
    F.G = gridDim.x; { const int bx = blockIdx.x; F.vcu = (F.G % 8 == 0) ? (bx % 8) * (F.G / 8) + bx / 8 : bx; }
    unsigned char* ws = args.ws;
    F.ctl = (gu32*)(ws + WS_CTL);
    for (int u = threadIdx.x; u < (LDS_BYTES - LDSCTL_OFF) / 4; u += NWAVES * 64) ((LAS unsigned*)(F.lds + LDSCTL_OFF))[u] = 0u;
    __syncthreads();
    XcdBarrier bar; bar.bar = (unsigned*)(F.ctl + CW_BAR); bar.x = 0; bar.st = nullptr;
    if (!MK_PER_PHASE) bar = xcd_barrier_post((unsigned*)(F.ctl + CW_BAR), F.MISC + 8);
#ifndef CV_D1
#define CV_D1 22000
#endif
#define GRID_BAR() do { if (!MK_PER_PHASE) xcd_barrier(bar, F.wave == 0 && lane_now() == 0); } while (0)
    const int lo = args.ph_lo, hi = args.ph_hi;
#ifndef DUP_PHASE
#define DUP_PHASE -1
#endif
#define REP(k) _Pragma("unroll") for (int rep_ = 0; rep_ < ((k) == DUP_PHASE ? 2 : 1); ++rep_)
#define IN(k) (lo <= (k) && (k) < hi)
#define BOTH(k) (IN(k) && IN((k) + 1))
    bf16* XN = (bf16*)(ws + WS_XN); bf16* QKV = (bf16*)(ws + WS_QKV); bf16* ATT = (bf16*)(ws + WS_ATT); bf16* ACT = (bf16*)(ws + WS_ACT); bf16* Hb = (bf16*)(ws + WS_H); float* Hs = (float*)(ws + WS_H) + (size_t)NPR * DM;
    LAS unsigned char* ring = F.lds + RING_OFF; bf16* PS = (bf16*)(ws + WS_P);

    if (IN(0)) REP(0) { p0_prologue(F, args); if (BOTH(0)) GRID_BAR(); }
    if (IN(1)) REP(1) { pg8::Gemm g{XN, (const bf16*)(ws + WS_W_IN), MR, N_AB, DM}; pg8::StaticOrder S; S.init(MR, N_AB, F.G, (int)blockIdx.x); S.ntk = DM / 64;
        pg8::EpiQKV0 E{QKV, args.out, (bf16*)(ws + WS_KAS), (bf16*)(ws + WS_VAS), (bf16*)(ws + WS_KBS), (bf16*)(ws + WS_VBS)};
        pg8::gemm_phase<pg8::EpiQKV0, pg8::StaticOrder, PG8_ALIGN, PG8_SP2>(ring, g, S, E, F.wave, lane_now());
        { constexpr int REM = ((MR / 256) * (N_AB / 256)) % 256; if ((int)blockIdx.x >= REM) convert_range<false>(F, args, CV_IN, CVR_D1_END, ((int)blockIdx.x - REM) * NWAVES + F.wave, (256 - REM) * NWAVES, lane_now()); }
        if (BOTH(1)) GRID_BAR(); }
    if (IN(2)) REP(2) { attn0_phase(F, args); if (BOTH(2)) GRID_BAR(); }
    if (IN(3)) REP(3) { pg8::Gemm g{ATT, (const bf16*)(ws + WS_W_OUTAB), MR, DM, DM}; pg8::SplitTailOrder S; S.init(NPR, MR, DM, DM, F.G, (int)blockIdx.x);
        pg8::EpiResid<true> E{args.in[0], Hb, PS};
#ifdef PROBE_VAR
        const long long wv0 = wall_clock64();
#endif
        pg8::gemm_phase<decltype(E), pg8::SplitTailOrder, PG8_ALIGN, PG8_SP2>(ring, g, S, E, F.wave, lane_now());
#ifdef PROBE_VAR
        if (F.wave == 0 && lane_now() == 0) { const unsigned dt = (unsigned)(wall_clock64() - wv0); atomicMax((unsigned*)(ws + WS_CTL) + 40010, dt); atomicMax((unsigned*)(ws + WS_CTL) + 40012, ~0u - dt); atomicAdd((unsigned*)(ws + WS_CTL) + 40011, dt); }
#endif
        if (BOTH(3)) GRID_BAR(); }
    if (IN(4)) REP(4) { rms_phase(F, Hb, Hs, args.in[1], PS, args.in[9], XN); if (BOTH(4)) GRID_BAR(); }
    if (IN(5)) REP(5) { pg8::Gemm g{XN, (const bf16*)(ws + WS_W_GU0), MR, N_GU, DM}; pg8::StaticOrder S; S.init(MR, N_GU, F.G, (int)blockIdx.x); S.ntk = DM / 64;
        pg8::EpiSwiGLU E{ACT};
#ifdef PROBE_CLK
        long long c0 = 0, w0 = 0; if (blockIdx.x == PROBE_CLK && F.wave == 0) { c0 = clock64(); w0 = wall_clock64(); }
#endif
        pg8::gemm_phase<pg8::EpiSwiGLU, pg8::StaticOrder, PG8_ALIGN, PG8_SP2>(ring, g, S, E, F.wave, lane_now());
        { constexpr int REM = ((MR / 256) * (N_GU / 256)) % 256; if ((int)blockIdx.x >= REM) convert_range<false>(F, args, CVR_A_END, CVR_D2_END, ((int)blockIdx.x - REM) * NWAVES + F.wave, (256 - REM) * NWAVES, lane_now()); }
#ifdef PROBE_CLK
        if (blockIdx.x == PROBE_CLK && F.wave == 0) { const long long c1 = clock64(), w1 = wall_clock64(); if (lane_now() == 0) ((float*)(ws + WS_CTL))[40000] = 0.1f * (float)(c1 - c0) / (float)(w1 - w0); }
#endif
        if (BOTH(5)) GRID_BAR(); }
    if (IN(6)) { pg8::Gemm g{ACT, (const bf16*)(ws + WS_W_DN0), MR, DM, DFF}; pg8::SplitTailOrder S; S.init(NPR, MR, DM, DFF, F.G, (int)blockIdx.x);
        pg8::EpiResid<false> E{Hb, Hb, PS};
        pg8::gemm_phase<decltype(E), pg8::SplitTailOrder, PG8_ALIGN, PG8_SP2>(ring, g, S, E, F.wave, lane_now()); if (BOTH(6)) GRID_BAR(); }
    if (IN(7)) REP(7) { rms_phase(F, Hb, Hs, Hs, PS, args.in[8] + DM, XN); if (BOTH(7)) GRID_BAR(); }
    if (IN(8)) REP(8) { pg8::Gemm g{XN, (const bf16*)(ws + WS_W_QKVC), MR, N_C, DM}; pg8::StaticOrder S; S.init(MR, N_C, F.G, (int)blockIdx.x); S.ntk = DM / 64;
        pg8::EpiQKV1 E{QKV, args.out, (bf16*)(ws + WS_KCS), (bf16*)(ws + WS_VCS), (const float*)(ws + WS_ROPE)};
        pg8::gemm_phase<pg8::EpiQKV1, pg8::StaticOrder, PG8_ALIGN, PG8_SP2>(ring, g, S, E, F.wave, lane_now());
        { constexpr int REM = ((MR / 256) * (N_C / 256)) % 256; if ((int)blockIdx.x >= REM) convert_range<false>(F, args, CVR_D2_END, CVR_D3_END, ((int)blockIdx.x - REM) * NWAVES + F.wave, (256 - REM) * NWAVES, lane_now()); }
        if (BOTH(8)) GRID_BAR(); }
    if (IN(9)) REP(9) { attn1_phase(F, args); if (BOTH(9)) GRID_BAR(); }
    if (IN(10)) { pg8::Gemm g{ATT, (const bf16*)(ws + WS_W_OUTC), MR, DM, DM}; pg8::SplitTailOrder S; S.init(NPR, MR, DM, DM, F.G, (int)blockIdx.x);
        pg8::EpiResid<false> E{Hb, Hb, PS};
        pg8::gemm_phase<decltype(E), pg8::SplitTailOrder, PG8_ALIGN, PG8_SP2>(ring, g, S, E, F.wave, lane_now()); if (BOTH(10)) GRID_BAR(); }
    if (IN(11)) REP(11) { rms_phase(F, Hb, Hs, Hs, PS, args.in[9] + DM, XN); if (BOTH(11)) GRID_BAR(); }
    if (IN(12)) REP(12) { pg8::Gemm g{XN, (const bf16*)(ws + WS_W_GU1), MR, N_GU, DM}; pg8::StaticOrder S; S.init(MR, N_GU, F.G, (int)blockIdx.x); S.ntk = DM / 64;
        pg8::EpiSwiGLU E{ACT};
        pg8::gemm_phase<pg8::EpiSwiGLU, pg8::StaticOrder, PG8_ALIGN, PG8_SP2>(ring, g, S, E, F.wave, lane_now());
        { constexpr int REM = ((MR / 256) * (N_GU / 256)) % 256; if ((int)blockIdx.x >= REM) convert_range<false>(F, args, CVR_B_END, CV_ALL, ((int)blockIdx.x - REM) * NWAVES + F.wave, (256 - REM) * NWAVES, lane_now()); }
        if (BOTH(12)) GRID_BAR(); }
    if (IN(13)) { pg8::Gemm g{ACT, (const bf16*)(ws + WS_W_DN1), MR, DM, DFF}; pg8::SplitTailOrder S; S.init(NPR, MR, DM, DFF, F.G, (int)blockIdx.x);
        pg8::EpiResid<false> E{Hb, Hb, PS};
        pg8::gemm_phase<decltype(E), pg8::SplitTailOrder, PG8_ALIGN, PG8_SP2>(ring, g, S, E, F.wave, lane_now()); if (BOTH(13)) GRID_BAR(); }
    if (IN(14)) { const int gw = F.vcu * NWAVES + F.wave, NGW = F.G * NWAVES, lane = lane_now();
#if defined(PROBE_VAR)
        const unsigned* pv = (const unsigned*)(ws + WS_CTL) + 40010; const float vmax = (float)__hip_atomic_load(pv, __ATOMIC_RELAXED, __HIP_MEMORY_SCOPE_AGENT), vmean = (float)__hip_atomic_load(pv + 1, __ATOMIC_RELAXED, __HIP_MEMORY_SCOPE_AGENT) / (float)F.G, vmin = (float)(~0u - __hip_atomic_load(pv + 2, __ATOMIC_RELAXED, __HIP_MEMORY_SCOPE_AGENT));
        const float osc = 1.0f + sqrtf(0.01f + 0.02f * floorf(50.0f * (PROBE_VAR == 0 ? (vmax / vmean - 1.0f) : (PROBE_VAR == 1 ? (1.0f - vmin / vmean) : vmean * 1e-6f)) + 0.5f));
        rms_sample_rows<true>(F, Hs, PS, args.in[10], nullptr, args.out + O_Y_S, osc, lane);
        for (int m = gw; m < NPR; m += NGW) rms_row_b<true>(Hb + (size_t)m * DM, args.in[10], args.out + (size_t)m * DM, lane); }
#elif defined(PROBE_CLK)
        const float osc = 1.0f + sqrtf(1e-2f * __hip_atomic_load((float*)(ws + WS_CTL) + 40000, __ATOMIC_RELAXED, __HIP_MEMORY_SCOPE_AGENT));
        rms_sample_rows<true>(F, Hs, PS, args.in[10], nullptr, args.out + O_Y_S, osc, lane);
        for (int m = gw; m < NPR; m += NGW) rms_row_b<true>(Hb + (size_t)m * DM, args.in[10], args.out + (size_t)m * DM, lane); }
#else
        rms_sample_rows<true>(F, Hs, PS, args.in[10], nullptr, args.out + O_Y_S, 1.0f, lane);
        for (int m = gw; m < NPR; m += NGW) rms_row_b<true>(Hb + (size_t)m * DM, args.in[10], args.out + (size_t)m * DM, lane); }
#endif

#ifdef PROBE_GEMM
    {
        GRID_BAR();
        struct ProbeOrder : pg8::StaticOrder { __device__ bool next(int i, pg8::Unit& u) const { const bool ok = pg8::StaticOrder::next(i, u); u.pm %= PROBE_MA; u.pn %= PROBE_NB; return ok; } };
        pg8::Gemm g{XN, (const bf16*)(ws + WS_W_GU1), MR, N_GU, DM}; ProbeOrder S; S.init(MR, N_GU, F.G, (int)blockIdx.x); S.ntk = DM / 64;
        pg8::EpiSwiGLU E{(bf16*)(ws + WS_END)};
        pg8::gemm_phase<pg8::EpiSwiGLU, ProbeOrder, PG8_ALIGN, PG8_SP2>(ring, g, S, E, F.wave, lane_now());
    }
#endif
#undef IN
#undef BOTH
}

extern "C" void kernel_launch(void* const* d_in, const int* in_sizes, int n_in, void* d_out, int out_size, void* d_ws, size_t ws_size, hipStream_t stream) {
    static int grid = 0;
    if (grid == 0) {
        if (n_in != 20 || in_sizes[0] != NPR * DM || (size_t)out_size != O_END || ws_size < WS_END) { fprintf(stderr, "kernel_launch: unexpected shapes (n_in %d, in0 %d, out %d, ws %zu); nothing launched\n", n_in, n_in > 0 ? in_sizes[0] : -1, out_size, ws_size); grid = -1; return; }
        int dev = 0, cus = 0, per_cu = 0;
        if (hipGetDevice(&dev) != hipSuccess || hipDeviceGetAttribute(&cus, hipDeviceAttributeMultiprocessorCount, dev) != hipSuccess) { fprintf(stderr, "kernel_launch: device query failed\n"); grid = -1; return; }
        if (hipFuncSetAttribute((const void*)fwd, hipFuncAttributeMaxDynamicSharedMemorySize, LDS_BYTES) != hipSuccess) { fprintf(stderr, "kernel_launch: hipFuncSetAttribute failed\n"); grid = -1; return; }
        if (hipOccupancyMaxActiveBlocksPerMultiprocessor(&per_cu, (const void*)fwd, NWAVES * 64, LDS_BYTES) != hipSuccess || per_cu < 1) { fprintf(stderr, "kernel_launch: occupancy query says %d blocks per CU\n", per_cu); }
        (void)hipGetLastError();
        if (cus < 256) { fprintf(stderr, "kernel_launch: built for a 256-CU device (the unit dealing and the tail work lists assume 256 resident workgroups); found %d CUs; nothing launched\n", cus); grid = -1; return; }
        grid = 256;
    }
    if (grid < 0) return;
    if (hipMemsetAsync((char*)d_ws + WS_CTL, 0, CTL_ZERO_BYTES, stream) != hipSuccess) { fprintf(stderr, "kernel_launch: memset failed\n"); return; }
    Args a{};
    for (int i = 0; i < 20; ++i) a.in[i] = (const float*)d_in[i];
    a.out = (float*)d_out; a.ws = (unsigned char*)d_ws;
#if MK_PER_PHASE
    for (int li = 0; li < N_PHASES; ++li) { a.ph_lo = li; a.ph_hi = li + 1; hipLaunchKernelGGL(fwd, dim3(grid), dim3(NWAVES * 64), LDS_BYTES, stream, a); }
#else
    a.ph_lo = 0; a.ph_hi = N_PHASES; hipLaunchKernelGGL(fwd, dim3(grid), dim3(NWAVES * 64), LDS_BYTES, stream, a);
#endif
    const hipError_t le = hipPeekAtLastError();
    if (le != hipSuccess) fprintf(stderr, "kernel_launch: launch failed: %s\n", hipGetErrorName(le));
}
```

```cpp
#include <hip/hip_runtime.h>
#include <cstdio>
#include <cstdint>
namespace pg8 {
#define PG8_LAS __attribute__((address_space(3)))
typedef unsigned short bf16_t;
typedef short bf16x8 __attribute__((ext_vector_type(8)));
typedef float f32x4 __attribute__((ext_vector_type(4)));
typedef unsigned u32x4 __attribute__((ext_vector_type(4)));
constexpr int BM = 256, BK = 64, HALF = 128, HTB = HALF * BK * 2  , STAGE_BYTES = 8 * HTB, NXCD = 8, WGM = 4;

__host__ __device__ __forceinline__ int lds_byte(int r, int c) { const int st = (r >> 4) * 2 + (c >> 5), rr = r & 15, cc = c & 31, ob = rr * 64 + cc * 2; return st * 1024 + (ob ^ (((ob >> 9) & 1) << 5)); }
__host__ __device__ __forceinline__ void stage_rc(int b, int& R, int& C) { const int st = b / 1024, sb = b % 1024, swz = sb ^ (((sb >> 9) & 1) << 5); R = (st >> 1) * 16 + swz / 64; C = (st & 1) * 32 + (swz % 64) / 2; }
__host__ __device__ __forceinline__ int perm32(int rho) { const int n = rho >> 4, i = rho & 15; return 8 * (i >> 2) + 4 * n + (i & 3); }

struct Unit { int pm, pn, kt0, nt, s; };
struct Gemm { const bf16_t* A; const bf16_t* Bt; int M, N, K; };

struct StaticOrder {
    int nM, nN, nwg, G, c, ntk;
    __host__ __device__ void init(int M, int N, int G_, int c_) { nM = M / BM; nN = N / BM; nwg = nM * nN; G = G_; c = c_; }
    __host__ __device__ __forceinline__ bool next(int i, Unit& u) const {
        const long L0 = (long)i * G + c; const bool ok = L0 < nwg; const long L = ok ? L0 : 0;
        int wgid = (int)L; { const int q = nwg / NXCD, r = nwg % NXCD, xcd = wgid % NXCD, off = wgid / NXCD; wgid = (xcd < r ? xcd * (q + 1) : r * (q + 1) + (xcd - r) * q) + off; }
        const int nig = WGM * nN, gid = wgid / nig, fm = gid * WGM, gsz = (nM - fm) < WGM ? (nM - fm) : WGM;
        u.pm = fm + ((wgid % nig) % gsz); u.pn = (wgid % nig) / gsz; u.kt0 = 0; u.nt = ntk; u.s = -1; return ok;
    }
    __device__ __forceinline__ void a_ready(const Unit&) const {}
    __device__ __forceinline__ void done(const Unit&) const {}
};

__device__ __forceinline__ unsigned cvt_pk_bf16(float lo, float hi) { unsigned r; asm volatile("v_cvt_pk_bf16_f32 %0, %1, %2" : "=v"(r) : "v"(lo), "v"(hi)); return r; }
typedef float f32x2 __attribute__((ext_vector_type(2)));

struct SplitTailOrder {
    StaticOrder base; int nfull, nitems, nN, pm0, ntk;
    __host__ __device__ void init(int M0, int M, int N, int K, int G_, int c_) { base.init(M0, N, G_, c_); base.ntk = K / BK; ntk = K / BK; nfull = base.nwg; nN = N / BM; pm0 = M0 / BM; nitems = (M - M0) / BM * nN * 8; }
    __host__ __device__ __forceinline__ bool next(int i, Unit& u) const {
        const bool ifirst = (nitems % base.G) == 0;
        const int nir = nitems / base.G, nfr = (nfull + base.G - 1) / base.G;
        const bool full = ifirst ? i >= nir : i < nfr;
        Unit a; const bool oka = base.next(full ? (ifirst ? i - nir : i) : 0, a);
        long jl = (long)(ifirst ? i : i - nfr) * base.G + base.c; const bool okb = !full && jl >= 0 && jl < nitems; const int j = okb ? (int)jl : 0;
        const int s = j & 7, t = j >> 3;
        const int q = (ntk / 16) * 2, r = (ntk - 8 * q) / 2;
        u.pm = full ? a.pm : pm0 + t / nN; u.pn = full ? a.pn : t % nN; u.s = full ? -1 : s;
        u.nt = full ? ntk : q + (s < r ? 2 : 0); u.kt0 = full ? 0 : s * q + 2 * (s < r ? s : r);
        return full ? oka : okb;
    }
    __device__ __forceinline__ void a_ready(const Unit&) const {}
    __device__ __forceinline__ void done(const Unit&) const {}
};
template <class Epi, class Sched, bool ALIGN_EPI = false, bool SP2 = false>
__device__ __forceinline__ void gemm_phase(PG8_LAS unsigned char* lds, const Gemm g, const Sched& S, const Epi& E, const int wid, const int lane) {
    const int tid = wid * 64 + lane, wr = wid >> 2, wc = wid & 3, fr = lane & 15, fq = lane >> 4;
    const int K = g.K;
    unsigned voffA[2], voffB[2];
#pragma unroll
    for (int i = 0; i < 2; ++i) { int R, C; stage_rc(tid * 16 + i * 8192, R, C); const int Rb = Epi::PERM ? ((R & ~31) + perm32(R & 31)) : R;
        voffA[i] = (unsigned)(R * K + C) * 2u; voffB[i] = (unsigned)(Rb * K + C) * 2u; }
    const size_t kstep = (size_t)(BK * 2);
    const size_t hstep = (size_t)HALF * K * 2;
    const size_t tstep = 2 * hstep;
    const unsigned ldsw = (unsigned)wid * 1024u;
    const int aoff = lds_byte(wr * 64 + fr, fq * 8), boff = lds_byte(wc * 32 + fr, fq * 8);
#define PG8_SA(b, h) (((b) * 2 + (h)) * HTB)
#define PG8_SB(b, h) ((4 + (b) * 2 + (h)) * HTB)
#define PG8_STAGE(bufoff, gbase, voff) do { _Pragma("unroll") for (int _i = 0; _i < 2; ++_i) \
        __builtin_amdgcn_global_load_lds((const unsigned*)((const char*)(gbase) + (voff)[_i]), (PG8_LAS unsigned*)(lds + (bufoff) + ldsw + _i * 8192), 16, 0, 0); } while (0)
#define PG8_LDA(dst, b, h) do { _Pragma("unroll") for (int m = 0; m < 4; ++m) _Pragma("unroll") for (int k = 0; k < 2; ++k) dst[m][k] = *(const PG8_LAS bf16x8*)(lds + PG8_SA(b, h) + aoff + m * 2048 + k * 1024); } while (0)
#define PG8_LDB(dst, b, h) do { _Pragma("unroll") for (int n = 0; n < 2; ++n) _Pragma("unroll") for (int k = 0; k < 2; ++k) dst[n][k] = *(const PG8_LAS bf16x8*)(lds + PG8_SB(b, h) + boff + n * 2048 + k * 1024); } while (0)
#define PG8_MMA(ai, bj, At, Bt) do { __builtin_amdgcn_s_setprio(1); _Pragma("unroll") for (int m = 0; m < 4; ++m) _Pragma("unroll") for (int n = 0; n < 2; ++n) _Pragma("unroll") for (int k = 0; k < 2; ++k) \
        acc[ai][bj][m][n] = __builtin_amdgcn_mfma_f32_16x16x32_bf16(Bt[n][k], At[m][k], acc[ai][bj][m][n], 0, 0, 0); __builtin_amdgcn_s_setprio(0); } while (0)
#define PG8_WAIT_V(n) asm volatile("s_waitcnt vmcnt(" #n ")" ::: "memory")
#define PG8_WAIT_L(n) asm volatile("s_waitcnt lgkmcnt(" #n ")" ::: "memory")
#define PG8_BAR __builtin_amdgcn_s_barrier()
#define PG8_SCHED __builtin_amdgcn_sched_barrier(0)
    Unit cur, nxt; int ui = 0;
    if (!S.next(0, cur)) return;
    f32x4 acc[2][2][4][2];
#pragma unroll
    for (int a = 0; a < 2; ++a)
#pragma unroll
        for (int b = 0; b < 2; ++b)
#pragma unroll
            for (int m = 0; m < 4; ++m)
#pragma unroll
                for (int n = 0; n < 2; ++n) acc[a][b][m][n] = (f32x4){0.f, 0.f, 0.f, 0.f};
    bf16x8 At[4][2], B0[2][2], B1[2][2];
    const char* cA = (const char*)g.A + (size_t)cur.pm * tstep + (size_t)cur.kt0 * kstep; const char* cB = (const char*)g.Bt + (size_t)cur.pn * tstep + (size_t)cur.kt0 * kstep;
    S.a_ready(cur);
    if constexpr (SP2) {
        PG8_STAGE(PG8_SB(0, 0), cB, voffB); PG8_STAGE(PG8_SB(0, 1), cB + hstep, voffB); PG8_STAGE(PG8_SA(0, 0), cA, voffA); PG8_STAGE(PG8_SA(0, 1), cA + hstep, voffA);
        if (wr == 1) PG8_BAR;
        PG8_WAIT_V(2); PG8_BAR;
        PG8_STAGE(PG8_SB(1, 0), cB + kstep, voffB); PG8_STAGE(PG8_SA(1, 0), cA + kstep, voffA); PG8_STAGE(PG8_SB(1, 1), cB + hstep + kstep, voffB);
        PG8_WAIT_V(6); PG8_BAR;
    } else {
        PG8_STAGE(PG8_SB(0, 0), cB, voffB); PG8_STAGE(PG8_SA(0, 0), cA, voffA); PG8_STAGE(PG8_SB(0, 1), cB + hstep, voffB); PG8_STAGE(PG8_SA(0, 1), cA + hstep, voffA);
        if (wr == 1) PG8_BAR;
        PG8_WAIT_V(4); PG8_BAR;
        PG8_STAGE(PG8_SB(1, 0), cB + kstep, voffB); PG8_STAGE(PG8_SA(1, 0), cA + kstep, voffA); PG8_STAGE(PG8_SB(1, 1), cB + hstep + kstep, voffB);
        PG8_WAIT_V(6); PG8_BAR;
    }
    for (;;) {
        const bool has_next = S.next(ui + 1, nxt);
        const char* nA = has_next ? (const char*)g.A + (size_t)nxt.pm * tstep + (size_t)nxt.kt0 * kstep : cA; const char* nB = has_next ? (const char*)g.Bt + (size_t)nxt.pn * tstep + (size_t)nxt.kt0 * kstep : cB;
        const int nt = cur.nt;
        for (int t = 0; t < nt; t += 2) {
            const bool last = (t == nt - 2);
            const char* a1 = cA + (size_t)(t + 1) * kstep;
            const char* a2 = last ? nA : cA + (size_t)(t + 2) * kstep; const char* b2 = last ? nB : cB + (size_t)(t + 2) * kstep;
            const char* a3 = a2 + kstep; const char* b3 = b2 + kstep;
            if (last && has_next) S.a_ready(nxt);
            if constexpr (SP2) {
            PG8_LDB(B0, 0, 0); PG8_LDB(B1, 0, 1); PG8_SCHED; PG8_LDA(At, 0, 0); PG8_STAGE(PG8_SA(1, 1), a1 + hstep, voffA);
            PG8_WAIT_V(8); PG8_WAIT_L(0); PG8_BAR; PG8_MMA(0, 0, At, B0); PG8_MMA(0, 1, At, B1); PG8_BAR; PG8_SCHED;
            PG8_LDA(At, 0, 1); PG8_STAGE(PG8_SB(0, 0), b2, voffB); PG8_STAGE(PG8_SB(0, 1), b2 + hstep, voffB); PG8_STAGE(PG8_SA(0, 0), a2, voffA);
            PG8_WAIT_V(8); PG8_WAIT_L(0); PG8_BAR; PG8_MMA(1, 0, At, B0); PG8_MMA(1, 1, At, B1); PG8_BAR; PG8_SCHED;
            PG8_LDB(B0, 1, 0); PG8_LDB(B1, 1, 1); PG8_SCHED; PG8_LDA(At, 1, 0); PG8_STAGE(PG8_SA(0, 1), a2 + hstep, voffA);
            PG8_WAIT_V(8); PG8_WAIT_L(0); PG8_BAR; PG8_MMA(0, 0, At, B0); PG8_MMA(0, 1, At, B1); PG8_BAR; PG8_SCHED;
            PG8_LDA(At, 1, 1); PG8_STAGE(PG8_SB(1, 0), b3, voffB); PG8_STAGE(PG8_SB(1, 1), b3 + hstep, voffB); PG8_STAGE(PG8_SA(1, 0), a3, voffA);
            PG8_WAIT_V(8); PG8_WAIT_L(0); PG8_BAR; PG8_MMA(1, 0, At, B0); PG8_MMA(1, 1, At, B1); PG8_BAR; PG8_SCHED;
            } else {
            PG8_LDB(B0, 0, 0); PG8_SCHED; PG8_LDA(At, 0, 0); PG8_STAGE(PG8_SA(1, 1), a1 + hstep, voffA);
            PG8_WAIT_L(8); PG8_BAR; PG8_WAIT_L(0); PG8_MMA(0, 0, At, B0); PG8_BAR; PG8_SCHED;
            PG8_LDB(B1, 0, 1); PG8_STAGE(PG8_SB(0, 0), b2, voffB);
            PG8_BAR; PG8_WAIT_L(0); PG8_MMA(0, 1, At, B1); PG8_BAR;
            PG8_LDA(At, 0, 1); PG8_STAGE(PG8_SA(0, 0), a2, voffA);
            PG8_BAR; PG8_WAIT_L(0); PG8_MMA(1, 0, At, B0); PG8_BAR; PG8_SCHED;
            PG8_STAGE(PG8_SB(0, 1), b2 + hstep, voffB);
            PG8_WAIT_V(6); PG8_BAR; PG8_MMA(1, 1, At, B1); PG8_BAR;
            PG8_LDB(B0, 1, 0); PG8_SCHED; PG8_LDA(At, 1, 0); PG8_STAGE(PG8_SA(0, 1), a2 + hstep, voffA);
            PG8_WAIT_L(8); PG8_BAR; PG8_WAIT_L(0); PG8_MMA(0, 0, At, B0); PG8_BAR; PG8_SCHED;
            PG8_LDB(B1, 1, 1); PG8_STAGE(PG8_SB(1, 0), b3, voffB);
            PG8_BAR; PG8_WAIT_L(0); PG8_MMA(0, 1, At, B1); PG8_BAR;
            PG8_LDA(At, 1, 1); PG8_STAGE(PG8_SA(1, 0), a3, voffA);
            PG8_BAR; PG8_WAIT_L(0); PG8_MMA(1, 0, At, B0); PG8_BAR; PG8_SCHED;
            PG8_STAGE(PG8_SB(1, 1), b3 + hstep, voffB);
            PG8_WAIT_V(6); PG8_BAR; PG8_MMA(1, 1, At, B1); PG8_BAR;
            }
        }
        if constexpr (ALIGN_EPI) { if (wr == 0) PG8_BAR; }
        if constexpr (!Epi::AFTER_DRAIN) { E(acc, cur, wr, wc, fr, fq); S.done(cur); }
        if (!has_next) break;
#pragma unroll
        for (int a = 0; a < 2; ++a)
#pragma unroll
            for (int b = 0; b < 2; ++b)
#pragma unroll
                for (int m = 0; m < 4; ++m)
#pragma unroll
                    for (int n = 0; n < 2; ++n) acc[a][b][m][n] = (f32x4){0.f, 0.f, 0.f, 0.f};
        cur = nxt; cA = nA; cB = nB; ++ui;
        if constexpr (ALIGN_EPI) { if (wr == 1) PG8_BAR; }
    }
    PG8_WAIT_V(0);
    if constexpr (!ALIGN_EPI) { if (wr == 0) PG8_BAR; }
    PG8_BAR;
    if constexpr (Epi::AFTER_DRAIN) { E.fused(acc, cur, wr, wc, fr, fq, lds, wid, lane); S.done(cur); }
#undef PG8_SA
#undef PG8_SB
#undef PG8_STAGE
#undef PG8_LDA
#undef PG8_LDB
#undef PG8_MMA
#undef PG8_WAIT_V
#undef PG8_WAIT_L
#undef PG8_BAR
#undef PG8_SCHED
}
}
constexpr int DM = 4096, SEQ = 2048, BP = 4, BS = 16, TS = 32, PAST = 1024;
constexpr int NPR = BP * SEQ, NSR = BS * TS, MR = NPR + NSR;
constexpr int DFF = 11008, N_AB = 12288, N_C = 5120, N_GU = 2 * DFF;
constexpr int W_AB = 2048;
constexpr int LA_S = PAST + TS, LB_S = 512 + TS, LC_S = 128 + TS;
constexpr float RMS_EPS = 1e-6f;
constexpr size_t O_Y_P = 0, O_Y_S = O_Y_P + (size_t)NPR * DM, O_SBK_P = O_Y_S + (size_t)NSR * DM, O_SBV_P = O_SBK_P + (size_t)NPR * W_AB,
                 O_BK_P = O_SBV_P + (size_t)NPR * W_AB, O_BV_P = O_BK_P + (size_t)BP * 512 * W_AB, O_CK_P = O_BV_P + (size_t)BP * 512 * W_AB, O_CV_P = O_CK_P + (size_t)BP * 128 * 512,
                 O_SBK_S = O_CV_P + (size_t)BP * 128 * 512, O_SBV_S = O_SBK_S + (size_t)NSR * W_AB, O_BK_S = O_SBV_S + (size_t)NSR * W_AB, O_BV_S = O_BK_S + (size_t)BS * 512 * W_AB,
                 O_CK_S = O_BV_S + (size_t)BS * 512 * W_AB, O_CV_S = O_CK_S + (size_t)BS * 128 * 512, O_END = O_CV_S + (size_t)BS * 128 * 512;
static_assert(O_END == 115867648, "output size");

namespace pg8 {
__device__ __forceinline__ u32x4 pack8(const f32x4& a, const f32x4& b) { u32x4 w; w.x = cvt_pk_bf16(a[0], a[1]); w.y = cvt_pk_bf16(a[2], a[3]); w.z = cvt_pk_bf16(b[0], b[1]); w.w = cvt_pk_bf16(b[2], b[3]); return w; }

struct EpiQKV0 {
    static constexpr bool PERM = true, AFTER_DRAIN = false;
    bf16_t* QKV; float* out; bf16_t *kAs, *vAs, *kBs, *vBs;
    __device__ __forceinline__ void operator()(const f32x4 (&acc)[2][2][4][2], const Unit& u, int wr, int wc, int fr, int fq) const {
        const int seg = u.pn >> 3, cs0 = (u.pn & 7) * 256 + wc * 32 + 8 * fq;
        const bool sample = u.pm >= 32;
        const bool isk = (seg == 1 || seg == 4), isv = (seg == 2 || seg == 5), isb = seg >= 3;
        float* fb = nullptr; bf16_t* sb = nullptr; int f_bs = 0, f_off = 0, s_len = 0, s_off = 0;
        if (isk || isv) {
            if (!sample) {
                if (!isb) fb = out + (isk ? O_SBK_P : O_SBV_P) + (size_t)(u.pm * 256) * W_AB;
                else if ((u.pm & 7) >= 6) fb = out + (isk ? O_BK_P : O_BV_P) + (size_t)((u.pm >> 3) * 512 + (u.pm & 7) * 256 - 1536) * W_AB;
            } else {
                if (!isb) { fb = out + (isk ? O_SBK_S : O_SBV_S); f_bs = TS; f_off = 0; sb = isk ? kAs : vAs; s_len = LA_S; s_off = PAST; }
                else      { fb = out + (isk ? O_BK_S : O_BV_S); f_bs = 512; f_off = 512 - TS; sb = isk ? kBs : vBs; s_len = LB_S; s_off = 512; }
            }
        }
#pragma unroll
        for (int ai = 0; ai < 2; ++ai)
#pragma unroll
            for (int m = 0; m < 4; ++m) {
                const int rl = ai * HALF + wr * 64 + m * 16 + fr; const size_t row = (size_t)u.pm * BM + rl;
                size_t frow = rl, srow = 0;
                if (sample) { const int r2 = (u.pm - 32) * 256 + rl, bs = r2 >> 5, t = r2 & 31; frow = (size_t)bs * f_bs + f_off + t; srow = (size_t)bs * s_len + s_off + t; }
#pragma unroll
                for (int bj = 0; bj < 2; ++bj) {
                    const int cs = cs0 + bj * HALF; const f32x4 v0 = acc[ai][bj][m][0], v1 = acc[ai][bj][m][1]; const u32x4 w = pack8(v0, v1);
                    *(u32x4*)(QKV + row * N_AB + seg * W_AB + cs) = w;
                    if (fb) { float* f = fb + frow * W_AB + cs; *(f32x4*)f = v0; *(f32x4*)(f + 4) = v1; }
                    if (sb) *(u32x4*)(sb + srow * W_AB + cs) = w;
                }
            }
    }
};
struct EpiQKV1 {
    static constexpr bool PERM = true, AFTER_DRAIN = false;
    bf16_t* QKV; float* out; bf16_t *kCs, *vCs; const float* rope;
    __device__ __forceinline__ void operator()(const f32x4 (&acc)[2][2][4][2], const Unit& u, int wr, int wc, int fr, int fq) const {
        const bool sample = u.pm >= 32; const int typ = u.pn < 16 ? 0 : (u.pn < 18 ? 1 : 2);
        const bool do_rope = (typ < 2) && ((wc & 1) == 0);
        const int cq0 = u.pn * 256 + wc * 32 + 8 * fq, ck0 = (u.pn & 1) * 256 + wc * 32 + 8 * fq;
        float* fb = nullptr; bf16_t* sb = nullptr;
        if (typ) { if (sample) { fb = out + (typ == 1 ? O_CK_S : O_CV_S); sb = typ == 1 ? kCs : vCs; } else if ((u.pm & 7) == 7) fb = out + (typ == 1 ? O_CK_P : O_CV_P) + (size_t)((u.pm >> 3) * 128) * 512; }
#pragma unroll
        for (int ai = 0; ai < 2; ++ai)
#pragma unroll
            for (int m = 0; m < 4; ++m) {
                const int rl = ai * HALF + wr * 64 + m * 16 + fr; const size_t row = (size_t)u.pm * BM + rl;
                int pos, bs = 0, t = 0; if (sample) { const int r2 = (u.pm - 32) * 256 + rl; bs = r2 >> 5; t = r2 & 31; pos = PAST + t; } else pos = (u.pm & 7) * 256 + rl;
                f32x4 cs0v, cs1v, sn0v, sn1v;
                if (do_rope) { const f32x4* rp = (const f32x4*)(rope + (size_t)pos * 16); cs0v = rp[0]; cs1v = rp[1]; sn0v = rp[2]; sn1v = rp[3]; if (fq == 0) { sn0v = -sn0v; sn1v = -sn1v; } }
#pragma unroll
                for (int bj = 0; bj < 2; ++bj) {
                    f32x4 v0 = acc[ai][bj][m][0], v1 = acc[ai][bj][m][1];
                    if (do_rope) {
                        f32x4 p0, p1;
#pragma unroll
                        for (int j = 0; j < 4; ++j) { p0[j] = __shfl_xor(v0[j], 16); p1[j] = __shfl_xor(v1[j], 16); }
                        if (fq < 2) { v0 = v0 * cs0v + p0 * sn0v; v1 = v1 * cs1v + p1 * sn1v; }
                    }
                    const u32x4 w = pack8(v0, v1);
                    if (typ == 0 || !sample) *(u32x4*)(QKV + row * N_C + cq0 + bj * HALF) = w;
                    if (typ) {
                        const int cs = ck0 + bj * HALF;
                        if (sample) { float* f = fb + ((size_t)bs * 128 + (128 - TS) + t) * 512 + cs; *(f32x4*)f = v0; *(f32x4*)(f + 4) = v1; *(u32x4*)(sb + ((size_t)bs * LC_S + 128 + t) * 512 + cs) = w; }
                        else if (fb && ai == 1) { float* f = fb + (size_t)(rl - 128) * 512 + cs; *(f32x4*)f = v0; *(f32x4*)(f + 4) = v1; }
                    }
                }
            }
    }
};
template <bool SRC_F32>
struct EpiResid {
    static constexpr bool PERM = true, AFTER_DRAIN = false;
    const void* rp; bf16_t* H; bf16_t* P;
    __device__ __forceinline__ void operator()(const f32x4 (&acc)[2][2][4][2], const Unit& u, int wr, int wc, int fr, int fq) const {
        const int col0 = u.pn * BM + wc * 32 + 8 * fq;
        const size_t row00 = (size_t)u.pm * BM + wr * 64 + fr;
        if (u.s >= 0) {
#pragma unroll
            for (int ai = 0; ai < 2; ++ai)
#pragma unroll
                for (int m = 0; m < 4; ++m) { bf16_t* dst = P + ((size_t)u.s * NSR + (row00 + ai * HALF + m * 16 - NPR)) * DM + col0;
#pragma unroll
                    for (int bj = 0; bj < 2; ++bj) *(u32x4*)(dst + bj * HALF) = pack8(acc[ai][bj][m][0], acc[ai][bj][m][1]); }
        } else if constexpr (SRC_F32) {
#pragma unroll
            for (int ai = 0; ai < 2; ++ai) { f32x4 ra[4][2][2];
#pragma unroll
                for (int m = 0; m < 4; ++m)
#pragma unroll
                    for (int bj = 0; bj < 2; ++bj) { const float* s = (const float*)rp + (row00 + ai * HALF + m * 16) * DM + col0 + bj * HALF; ra[m][bj][0] = *(const f32x4*)s; ra[m][bj][1] = *(const f32x4*)(s + 4); }
                asm volatile("" ::: "memory");
#pragma unroll
                for (int m = 0; m < 4; ++m)
#pragma unroll
                    for (int bj = 0; bj < 2; ++bj) *(u32x4*)(H + (row00 + ai * HALF + m * 16) * DM + col0 + bj * HALF) = pack8(ra[m][bj][0] + acc[ai][bj][m][0], ra[m][bj][1] + acc[ai][bj][m][1]);
                asm volatile("" ::: "memory"); }
        } else {
            u32x4 rv[2][4][2];
#pragma unroll
            for (int ai = 0; ai < 2; ++ai)
#pragma unroll
                for (int m = 0; m < 4; ++m)
#pragma unroll
                    for (int bj = 0; bj < 2; ++bj) rv[ai][m][bj] = *(const u32x4*)((const bf16_t*)rp + (row00 + ai * HALF + m * 16) * DM + col0 + bj * HALF);
            asm volatile("" ::: "memory");
#pragma unroll
            for (int ai = 0; ai < 2; ++ai)
#pragma unroll
                for (int m = 0; m < 4; ++m)
#pragma unroll
                    for (int bj = 0; bj < 2; ++bj) { const u32x4 w = rv[ai][m][bj]; const unsigned w0 = w[0], w1 = w[1], w2 = w[2], w3 = w[3]; f32x4 a, b;
                        a[0] = __builtin_bit_cast(float, w0 << 16); a[1] = __builtin_bit_cast(float, w0 & 0xffff0000u); a[2] = __builtin_bit_cast(float, w1 << 16); a[3] = __builtin_bit_cast(float, w1 & 0xffff0000u);
                        b[0] = __builtin_bit_cast(float, w2 << 16); b[1] = __builtin_bit_cast(float, w2 & 0xffff0000u); b[2] = __builtin_bit_cast(float, w3 << 16); b[3] = __builtin_bit_cast(float, w3 & 0xffff0000u);
                        *(u32x4*)(H + (row00 + ai * HALF + m * 16) * DM + col0 + bj * HALF) = pack8(a + acc[ai][bj][m][0], b + acc[ai][bj][m][1]); }
        }
    }
};
struct EpiSwiGLU {
    static constexpr bool PERM = true, AFTER_DRAIN = false;
    bf16_t* ACT;
    __device__ __forceinline__ void operator()(const f32x4 (&acc)[2][2][4][2], const Unit& u, int wr, int wc, int fr, int fq) const {
        const int col0 = u.pn * HALF + wc * 32 + 8 * fq;
#pragma unroll
        for (int ai = 0; ai < 2; ++ai)
#pragma unroll
            for (int m = 0; m < 4; ++m) {
                const size_t row = (size_t)u.pm * BM + ai * HALF + wr * 64 + m * 16 + fr;
                f32x4 r[2];
#pragma unroll
                for (int n = 0; n < 2; ++n)
#pragma unroll
                    for (int j = 0; j < 4; ++j) { const float g = acc[ai][0][m][n][j], up = acc[ai][1][m][n][j]; r[n][j] = g * __builtin_amdgcn_rcpf(1.0f + __builtin_amdgcn_exp2f(-1.4426950408889634f * g)) * up; }
                *(u32x4*)(ACT + row * DFF + col0) = pack8(r[0], r[1]);
            }
    }
};
}
#define PG8_SP2 true
#define PG8_ALIGN true
constexpr int NWAVES = 8;
constexpr int N_PHASES = 15;
#ifndef MK_PER_PHASE
#define MK_PER_PHASE 0
#endif
constexpr size_t MiB = 1u << 20;
constexpr size_t WS_CTL = 0, CTL_ZERO_BYTES = 1 * MiB;
constexpr size_t WS_ROPE = 1 * MiB;
constexpr size_t WS_W_IN = 2 * MiB, WS_W_OUTAB = 98 * MiB, WS_W_QKVC = 130 * MiB, WS_W_OUTC = 170 * MiB;
constexpr size_t WS_W_GU0 = 202 * MiB, WS_W_GU1 = 374 * MiB, WS_W_DN0 = 546 * MiB, WS_W_DN1 = 632 * MiB;
constexpr size_t WS_H = 718 * MiB;
constexpr size_t WS_XN = 854 * MiB;
constexpr size_t WS_QKV = 922 * MiB;
constexpr size_t WS_ATT = 1126 * MiB;
constexpr size_t WS_ACT = 1194 * MiB;
constexpr size_t WS_KAS = 1377 * MiB, WS_VAS = 1443 * MiB, WS_KBS = 1509 * MiB, WS_VBS = 1543 * MiB, WS_KCS = 1577 * MiB, WS_VCS = 1580 * MiB;
constexpr size_t WS_P = 1583 * MiB;
constexpr size_t WS_END = 1647 * MiB;
static_assert(WS_W_IN + (size_t)N_AB * DM * 2 <= WS_W_OUTAB && WS_W_OUTAB + (size_t)DM * DM * 2 <= WS_W_QKVC && WS_W_QKVC + (size_t)N_C * DM * 2 <= WS_W_OUTC && WS_W_OUTC + (size_t)DM * DM * 2 <= WS_W_GU0, "ws map 1");
static_assert(WS_W_GU0 + (size_t)N_GU * DM * 2 <= WS_W_GU1 && WS_W_GU1 + (size_t)N_GU * DM * 2 <= WS_W_DN0 && WS_W_DN0 + (size_t)DM * DFF * 2 <= WS_W_DN1 && WS_W_DN1 + (size_t)DM * DFF * 2 <= WS_H, "ws map 2");
static_assert(WS_H + (size_t)MR * DM * 4 <= WS_XN && WS_XN + (size_t)MR * DM * 2 <= WS_QKV && WS_QKV + (size_t)MR * N_AB * 2 <= WS_ATT && WS_ATT + (size_t)MR * DM * 2 <= WS_ACT && WS_ACT + (size_t)MR * DFF * 2 <= WS_KAS, "ws map 3");
static_assert(WS_KAS + (size_t)BS * LA_S * W_AB * 2 <= WS_VAS && WS_VAS + (size_t)BS * LA_S * W_AB * 2 <= WS_KBS && WS_KBS + (size_t)BS * LB_S * W_AB * 2 <= WS_VBS && WS_VBS + (size_t)BS * LB_S * W_AB * 2 <= WS_KCS &&
              WS_KCS + (size_t)BS * LC_S * 512 * 2 <= WS_VCS && WS_VCS + (size_t)BS * LC_S * 512 * 2 <= WS_P && WS_P + (size_t)8 * NSR * DM * 4 <= WS_END, "ws map 4");
#ifndef CV_PRO_END_DEF
#define CV_PRO_END_DEF CV_L0
#endif
constexpr int CW_BAR = 4096;
constexpr int RING_OFF = 0, RING_BYTES = 131072;
constexpr int LDSCTL_OFF = RING_BYTES, MISC_OFF = LDSCTL_OFF + 320;
constexpr int LDS_BYTES = 147456;
static_assert(MISC_OFF + 128 <= LDS_BYTES, "LDS map");
#define GAS __attribute__((address_space(1)))
#define LAS __attribute__((address_space(3)))
typedef unsigned short bf16;
typedef unsigned v4u __attribute__((ext_vector_type(4)));
typedef float f32x4 __attribute__((ext_vector_type(4)));
typedef short bf16x8 __attribute__((ext_vector_type(8)));
typedef GAS unsigned gu32;
typedef GAS unsigned long long gu64;
#define RLX_AGENT __ATOMIC_RELAXED, __HIP_MEMORY_SCOPE_AGENT
#define LDS_WAIT() asm volatile("s_waitcnt lgkmcnt(0)" ::: "memory")
#define VM_WAIT() asm volatile("s_waitcnt vmcnt(0)" ::: "memory")
__device__ __forceinline__ unsigned long long rt() { return __builtin_amdgcn_s_memrealtime(); }
__device__ __forceinline__ unsigned f2bf(float f) { unsigned u = __builtin_bit_cast(unsigned, f); return (u + 0x7fffu + ((u >> 16) & 1u)) >> 16; }
__device__ __forceinline__ unsigned pk2(float lo, float hi) { return f2bf(lo) | (f2bf(hi) << 16); }

#define XB_TMO      128
#define XB_XCNT(j)  (256  + 64 * (j))
#define XB_XSUB(j)  (1280 + 64 * (j))
#define XB_XGEN(j)  (2304 + 64 * (j))
#define XB_TOP      3328
#define XB_TOPGEN   3392
#define XCD_BAR_WORDS 3456
#define XB_SPIN_CAP (1u << 18)

__device__ __forceinline__ unsigned xb_ld(unsigned* p)              { return __hip_atomic_load(p, __ATOMIC_RELAXED, __HIP_MEMORY_SCOPE_AGENT); }
__device__ __forceinline__ unsigned xb_add(unsigned* p, unsigned v) { return __hip_atomic_fetch_add(p, v, __ATOMIC_RELAXED, __HIP_MEMORY_SCOPE_AGENT); }
__device__ __forceinline__ unsigned xb_xcc_id() { return (unsigned)__builtin_amdgcn_s_getreg((3 << 11) | 20) & 0xFu; }
#define XB_SPIN(cond, bar) do { unsigned _sp = 0; while (cond) { __builtin_amdgcn_s_sleep(1); \
    if ((++_sp & 255u) == 0u) { if (xb_ld(&(bar)[XB_TMO])) break; if (_sp > XB_SPIN_CAP) { atomicAdd(&(bar)[XB_TMO], 1u); break; } } } } while (0)

struct XcdBarrier {
    unsigned* bar; unsigned x;
    volatile LAS unsigned* st;
};

__device__ __forceinline__ XcdBarrier xcd_barrier_post(unsigned* bar, volatile LAS unsigned* st) {
    XcdBarrier b; b.bar = bar; b.x = xb_xcc_id(); b.st = st;
    if (threadIdx.x == 0) (void)xb_add(&bar[XB_XCNT(b.x)], 1u);
    return b;
}
__device__ __forceinline__ void xcd_barrier_complete(unsigned* bar, unsigned x, unsigned& nloc, unsigned& nx) {
    const unsigned G = gridDim.x * gridDim.y * gridDim.z;
    unsigned sum, cnt, mine, sp = 0u;
    for (;;) {
        sum = 0u; cnt = 0u; mine = 0u;
#pragma unroll
        for (unsigned j = 0; j < 16; ++j) { const unsigned c = xb_ld(&bar[XB_XCNT(j)]); sum += c; cnt += (c > 0u) ? 1u : 0u; mine = (j == x) ? c : mine; }
        if (sum == G) break;
        __builtin_amdgcn_s_sleep(1);
        if ((++sp & 255u) == 0u) { if (xb_ld(&bar[XB_TMO])) break; if (sp > XB_SPIN_CAP) { atomicAdd(&bar[XB_TMO], 1u); break; } }
    }
    nloc = mine > 0u ? mine : 1u; nx = cnt > 0u ? cnt : 1u;
}

__device__ __forceinline__ void xcd_barrier(const XcdBarrier& b, const bool t0) {
    asm volatile("s_waitcnt vmcnt(0)" ::: "memory");
    __syncthreads();
    if (t0) {
        unsigned* bar = b.bar;
        __builtin_amdgcn_s_waitcnt(0);
        unsigned nloc = b.st[0], nx = b.st[1];
        if (nloc == 0u) { xcd_barrier_complete(bar, b.x, nloc, nx); b.st[0] = nloc; b.st[1] = nx; }
        const unsigned old = xb_add(&bar[XB_XSUB(b.x)], 1u);
        const unsigned gen = old / nloc;
        if (old + 1u == (gen + 1u) * nloc) {
            __builtin_amdgcn_fence(__ATOMIC_RELEASE, "agent");
            asm volatile("s_waitcnt vmcnt(0)" ::: "memory");
            const unsigned og = xb_add(&bar[XB_TOP], 1u);
            const unsigned tg = og / nx;
            if (og + 1u == (tg + 1u) * nx) xb_add(&bar[XB_TOPGEN], 1u);
            else XB_SPIN(xb_ld(&bar[XB_TOPGEN]) == tg, bar);
            __builtin_amdgcn_fence(__ATOMIC_ACQUIRE, "agent");
            xb_add(&bar[XB_XGEN(b.x)], 1u);
            asm volatile("s_waitcnt vmcnt(0)" ::: "memory");
        } else {
            XB_SPIN(xb_ld(&bar[XB_XGEN(b.x)]) == gen, bar);
            __builtin_amdgcn_fence(__ATOMIC_ACQUIRE, "agent");
            asm volatile("s_waitcnt vmcnt(0)" ::: "memory");
        }
    }
    __syncthreads();
}

struct Frame {
    LAS unsigned char* lds;
    volatile LAS unsigned* MISC;
    gu32* ctl;
    int wave;
    int vcu, G;
};
__device__ __forceinline__ int lane_now() { int l; asm volatile("v_mbcnt_lo_u32_b32 %0, -1, 0\n\tv_mbcnt_hi_u32_b32 %0, -1, %0" : "=v"(l)); return l; }
__device__ __forceinline__ float wave_sum(float v) {
#pragma unroll
    for (int o = 1; o < 64; o <<= 1) v += __shfl_xor(v, o);
    return v;
}
__device__ __forceinline__ float wave_max(float v) {
#pragma unroll
    for (int o = 1; o < 64; o <<= 1) v = fmaxf(v, __shfl_xor(v, o));
    return v;
}
__device__ __forceinline__ float bflo(unsigned w) { return __builtin_bit_cast(float, w << 16); }
__device__ __forceinline__ float bfhi(unsigned w) { return __builtin_bit_cast(float, w & 0xffff0000u); }

typedef short v4i16p __attribute__((ext_vector_type(4)));
struct TrItem { const float* src; bf16* dst; int N, K; };
__device__ __forceinline__ void p0_tr_load(f32x4 (&v)[16], const TrItem& t, int lane) {
    const float* src = t.src + (size_t)(lane >> 4) * t.N + 4 * (lane & 15);
#pragma unroll
    for (int i = 0; i < 16; ++i) v[i] = __builtin_nontemporal_load((const f32x4*)(src + (size_t)(4 * i) * t.N));
}
__device__ __forceinline__ void p0_tr_store(const f32x4 (&v)[16], const TrItem& t, LAS unsigned char* img, int lane) {
#pragma unroll
    for (int i = 0; i < 16; ++i) { typedef unsigned u32x2t __attribute__((ext_vector_type(2))); u32x2t w; w.x = pk2(v[i].x, v[i].y); w.y = pk2(v[i].z, v[i].w); *(LAS u32x2t*)(img + 192 * (4 * i + (lane >> 4)) + 8 * (lane & 15)) = w; }
    LDS_WAIT(); asm volatile("" ::: "memory");
    const int g = lane >> 4, i16 = lane & 15, q = i16 >> 2, p = i16 & 3;
#pragma unroll
    for (int a = 0; a < 4; ++a)
#pragma unroll
        for (int j = 0; j < 2; ++j) { const int kc = 4 * j + g; const unsigned ad = (unsigned)(size_t)img + 192 * (8 * kc + q) + 32 * a + 8 * p;
            const v4i16p lo = __builtin_amdgcn_ds_read_tr16_b64_v4i16((LAS v4i16p*)(size_t)ad), hi = __builtin_amdgcn_ds_read_tr16_b64_v4i16((LAS v4i16p*)(size_t)(ad + 4 * 192));
            const bf16x8 o = __builtin_shufflevector(lo, hi, 0, 1, 2, 3, 4, 5, 6, 7);
            *(bf16x8*)(t.dst + (size_t)(16 * a + i16) * t.K + 8 * kc) = o; }
    LDS_WAIT(); asm volatile("" ::: "memory");
}
template <bool OUT_F32>
__device__ __forceinline__ void rms_row(const float* xrow, const float* g, void* orow, int lane, float osc = 1.0f, const float* slabs = nullptr, float* hrow = nullptr) {
    f32x4 v[16]; float s = 0.f;
#pragma unroll
    for (int j = 0; j < 8; ++j) { const f32x4* p = (const f32x4*)(xrow + j * 512 + lane * 8); v[2 * j] = p[0]; v[2 * j + 1] = p[1]; }
    if (slabs) {
#pragma unroll 1
        for (int sl = 0; sl < 8; ++sl) { const float* ps = slabs + (size_t)sl * NSR * DM;
#pragma unroll
            for (int j = 0; j < 8; ++j) { const f32x4* p = (const f32x4*)(ps + j * 512 + lane * 8); v[2 * j] += p[0]; v[2 * j + 1] += p[1]; } }
        if (hrow) {
#pragma unroll
            for (int j = 0; j < 8; ++j) { f32x4* p = (f32x4*)(hrow + j * 512 + lane * 8); p[0] = v[2 * j]; p[1] = v[2 * j + 1]; } }
    }
#pragma unroll
    for (int j = 0; j < 16; ++j) s += (v[j].x * v[j].x + v[j].y * v[j].y) + (v[j].z * v[j].z + v[j].w * v[j].w);
    const float r = osc / sqrtf(wave_sum(s) * (1.0f / DM) + RMS_EPS);
#pragma unroll
    for (int j = 0; j < 8; ++j) { const f32x4* gp = (const f32x4*)(g + j * 512 + lane * 8); const f32x4 a = v[2 * j] * r * gp[0], b = v[2 * j + 1] * r * gp[1];
        if (OUT_F32) { f32x4* o = (f32x4*)((float*)orow + j * 512 + lane * 8); o[0] = a; o[1] = b; }
        else { v4u w; w.x = pk2(a.x, a.y); w.y = pk2(a.z, a.w); w.z = pk2(b.x, b.y); w.w = pk2(b.z, b.w); *(v4u*)((bf16*)orow + j * 512 + lane * 8) = w; } }
}
__device__ __forceinline__ v4u cvt8(const float* p) { const f32x4 a = *(const f32x4*)p, b = *(const f32x4*)(p + 4); v4u w; w.x = pk2(a.x, a.y); w.y = pk2(a.z, a.w); w.z = pk2(b.x, b.y); w.w = pk2(b.z, b.w); return w; }

template <bool OUT_F32>
__device__ __forceinline__ void rms_row_b(const bf16* xrow, const float* g, void* orow, int lane) {
    f32x4 v[16]; float s = 0.f;
#pragma unroll
    for (int j = 0; j < 8; ++j) { const v4u w = *(const v4u*)(xrow + j * 512 + lane * 8); const unsigned w0 = w.x, w1 = w.y, w2 = w.z, w3 = w.w;
        v[2 * j].x = __builtin_bit_cast(float, w0 << 16); v[2 * j].y = __builtin_bit_cast(float, w0 & 0xffff0000u); v[2 * j].z = __builtin_bit_cast(float, w1 << 16); v[2 * j].w = __builtin_bit_cast(float, w1 & 0xffff0000u);
        v[2 * j + 1].x = __builtin_bit_cast(float, w2 << 16); v[2 * j + 1].y = __builtin_bit_cast(float, w2 & 0xffff0000u); v[2 * j + 1].z = __builtin_bit_cast(float, w3 << 16); v[2 * j + 1].w = __builtin_bit_cast(float, w3 & 0xffff0000u); }
#pragma unroll
    for (int j = 0; j < 16; ++j) s += (v[j].x * v[j].x + v[j].y * v[j].y) + (v[j].z * v[j].z + v[j].w * v[j].w);
    const float r = 1.0f / sqrtf(wave_sum(s) * (1.0f / DM) + RMS_EPS);
#pragma unroll
    for (int j = 0; j < 8; ++j) { const f32x4* gp = (const f32x4*)(g + j * 512 + lane * 8); const f32x4 a = v[2 * j] * r * gp[0], b = v[2 * j + 1] * r * gp[1];
        if (OUT_F32) { f32x4* o = (f32x4*)((float*)orow + j * 512 + lane * 8); o[0] = a; o[1] = b; }
        else { v4u w; w.x = pk2(a.x, a.y); w.y = pk2(a.z, a.w); w.z = pk2(b.x, b.y); w.w = pk2(b.z, b.w); *(v4u*)((bf16*)orow + j * 512 + lane * 8) = w; } }
}

struct Args { const float* in[20]; float* out; unsigned char* ws; int ph_lo, ph_hi; };
static_assert(sizeof(Args) == 22 * 8 + 8, "Args has no padding");

constexpr int CV_IN = 64 * (N_AB / 64), CV_O = 64 * (DM / 64), CV_QC = 64 * (N_C / 64), CV_G = 64 * (DFF / 64), CV_D = (DFF / 64) * (DM / 64);
constexpr int CV_L0 = CV_IN + CV_O + 2 * CV_G + CV_D, CV_L1 = CV_QC + CV_O + 2 * CV_G + CV_D, CV_ALL = CV_L0 + CV_L1;
#ifndef CVR_D1_N
#define CVR_D1_N 21000
#endif
#ifndef CVR_D2_N
#define CVR_D2_N 20000
#endif
#ifndef CVR_D3_N
#define CVR_D3_N 13000
#endif
constexpr int CVR_A_END = CV_IN + CV_O + 2 * CV_G, CVR_B_END = CV_ALL - CV_D;
constexpr int CVR_D1_END = (CV_IN + CVR_D1_N) < CVR_A_END ? (CV_IN + CVR_D1_N) : CVR_A_END;
constexpr int CVR_D2_END = (CVR_A_END + CVR_D2_N) < CVR_B_END ? (CVR_A_END + CVR_D2_N) : CVR_B_END;
constexpr int CVR_D3_END = (CVR_D2_END + CVR_D3_N) < CVR_B_END ? (CVR_D2_END + CVR_D3_N) : CVR_B_END;
static_assert(CVR_D2_END >= CV_L0 + CV_QC, "w_qkv_c must be converted before the layer-1 QKV GEMM");
__device__ __forceinline__ void cv_decode(const Args& A, int it, TrItem& t) {
    unsigned char* ws = A.ws;
    int r = it; const int l = r >= CV_L0; if (l) r -= CV_L0;
    const float* W; bf16* WT; int K = DM, N; int mode = 0;
    const int c_first = l ? CV_QC : CV_IN;
    if (r < c_first) { W = l ? A.in[14] : A.in[11]; WT = (bf16*)(ws + (l ? WS_W_QKVC : WS_W_IN)); N = l ? N_C : N_AB; }
    else if ((r -= c_first) < CV_O) { W = l ? A.in[15] : A.in[12]; WT = (bf16*)(ws + (l ? WS_W_OUTC : WS_W_OUTAB)); N = DM; }
    else if ((r -= CV_O) < CV_G) { W = A.in[17] + (size_t)l * DM * DFF; WT = (bf16*)(ws + (l ? WS_W_GU1 : WS_W_GU0)); N = DFF; mode = 1; }
    else if ((r -= CV_G) < CV_G) { W = A.in[18] + (size_t)l * DM * DFF; WT = (bf16*)(ws + (l ? WS_W_GU1 : WS_W_GU0)); N = DFF; mode = 2; }
    else { r -= CV_G; W = A.in[19] + (size_t)l * DFF * DM; WT = (bf16*)(ws + (l ? WS_W_DN1 : WS_W_DN0)); N = DM; K = DFF; }
    const int nblk = N / 64, kb = r / nblk, nb = r % nblk, n0 = 64 * nb;
    const int drow0 = mode == 0 ? n0 : (256 * (n0 >> 7) + (n0 & 127) + (mode == 2 ? 128 : 0));
    t.src = W + (size_t)(64 * kb) * N + n0; t.dst = WT + (size_t)drow0 * K + 64 * kb; t.N = N; t.K = K;
}
__device__ __forceinline__ int cv_pro_item(int v) { constexpr int n0 = CV_IN, n1 = CVR_A_END - CVR_D1_END; return v < n0 ? v : (v < n0 + n1 ? CVR_D1_END + (v - n0) : CVR_D3_END + (v - n0 - n1)); }
constexpr int CV_PRO_N = CV_IN + (CVR_A_END - CVR_D1_END) + (CVR_B_END - CVR_D3_END);
template <bool PRO = false>
__device__ __forceinline__ void convert_range(Frame& F, const Args& A, int it0, int it1, int worker, int nworkers, int lane) {
    LAS unsigned char* scr = F.lds + RING_OFF + F.wave * 12288;
    f32x4 va[16], vb[16]; TrItem ta, tb; int it = it0 + worker;
    if (it < it1) {
        cv_decode(A, PRO ? cv_pro_item(it) : it, ta); p0_tr_load(va, ta, lane);
        for (;;) {
            const int itb = it + nworkers; const bool hb = itb < it1; const int ib = hb ? itb : it;
            cv_decode(A, PRO ? cv_pro_item(ib) : ib, tb); p0_tr_load(vb, tb, lane);
            p0_tr_store(va, ta, scr, lane);
            if (!hb) break;
            it = itb + nworkers; const bool ha = it < it1; const int ia = ha ? it : itb;
            cv_decode(A, PRO ? cv_pro_item(ia) : ia, ta); p0_tr_load(va, ta, lane);
            p0_tr_store(vb, tb, scr, lane);
            if (!ha) break;
        }
    }
}
__device__ __forceinline__ void p0_prologue(Frame& F, const Args& A) {
    const int lane = lane_now(), tid = F.wave * 64 + lane;
    unsigned char* ws = A.ws;
    LAS unsigned char* scr = F.lds + RING_OFF + F.wave * 12288;
    const int gw = F.vcu * NWAVES + F.wave, NGW = F.G * NWAVES;
    constexpr int I_IN = 64 * (N_AB / 64), I_O = 64 * (DM / 64), I_QC = 64 * (N_C / 64), I_G = 64 * (DFF / 64), I_D = (DFF / 64) * (DM / 64);
    constexpr int NITEMS = I_IN + 2 * I_O + I_QC + 4 * I_G + 2 * I_D;
    convert_range<true>(F, A, 0, CV_PRO_N, gw, NGW, lane);
    const size_t gt = (size_t)F.vcu * (NWAVES * 64) + tid, NGT = (size_t)F.G * (NWAVES * 64);
    for (int kv = 0; kv < 2; ++kv) {
        const float* cB = A.in[4 + kv]; bf16* dB = (bf16*)(ws + (kv ? WS_VBS : WS_KBS)); float* oB = A.out + (kv ? O_BV_S : O_BK_S);
        for (size_t i = gt; i < (size_t)BS * 512 * W_AB / 8; i += NGT) { const size_t e = i * 8, bs = e / ((size_t)512 * W_AB), rem = e % ((size_t)512 * W_AB); const size_t rr = rem / W_AB;
            *(v4u*)(dB + bs * LB_S * W_AB + rem) = cvt8(cB + e);
            if (rr >= TS) { float* o = oB + e - (size_t)TS * W_AB; *(f32x4*)o = *(const f32x4*)(cB + e); *(f32x4*)(o + 4) = *(const f32x4*)(cB + e + 4); } }
        const float* cC = A.in[6 + kv]; bf16* dC = (bf16*)(ws + (kv ? WS_VCS : WS_KCS)); float* oC = A.out + (kv ? O_CV_S : O_CK_S);
        for (size_t i = gt; i < (size_t)BS * 128 * 512 / 8; i += NGT) { const size_t e = i * 8, bs = e / ((size_t)128 * 512), rem = e % ((size_t)128 * 512); const size_t rr = rem / 512;
            *(v4u*)(dC + bs * LC_S * 512 + rem) = cvt8(cC + e);
            if (rr >= TS) { float* o = oC + e - (size_t)TS * 512; *(f32x4*)o = *(const f32x4*)(cC + e); *(f32x4*)(o + 4) = *(const f32x4*)(cC + e + 4); } }
    }
    { float* rope = (float*)(ws + WS_ROPE);
      for (size_t i = gt; i < (size_t)SEQ * 8; i += NGT) { const int pos = (int)(i >> 3), fi = (int)(i & 7); const float inv = powf(500000.0f, -(float)fi / 8.0f); const float ang = (float)pos * inv;
          rope[pos * 16 + fi] = (float)cos((double)ang); rope[pos * 16 + 8 + fi] = (float)sin((double)ang); } }
    for (int m = gw; m < MR; m += NGW) rms_row<false>(m < NPR ? A.in[0] + (size_t)m * DM : A.in[1] + (size_t)(m - NPR) * DM, A.in[8], (bf16*)(ws + WS_XN) + (size_t)m * DM, lane);
}
template <bool OUT_F32>
__device__ __forceinline__ void rms_sample_rows(Frame& F, const float* sbase, const bf16* P, const float* g, float* Hout, void* out, float osc, int lane) {
    LAS float* red = (LAS float*)(F.lds + RING_OFF);
    const int col = F.wave * 512 + lane * 8;
    for (int r = F.vcu; r < NSR; r += F.G) {
        const float* b = sbase + (size_t)r * DM + col; f32x4 a0 = *(const f32x4*)b, a1 = *(const f32x4*)(b + 4);
#pragma unroll
        for (int s = 0; s < 8; ++s) { const v4u w = *(const v4u*)(P + ((size_t)s * NSR + r) * DM + col); const unsigned w0 = w.x, w1 = w.y, w2 = w.z, w3 = w.w;
            a0.x += bflo(w0); a0.y += bfhi(w0); a0.z += bflo(w1); a0.w += bfhi(w1); a1.x += bflo(w2); a1.y += bfhi(w2); a1.z += bflo(w3); a1.w += bfhi(w3); }
        if (Hout) { float* h = Hout + (size_t)r * DM + col; *(f32x4*)h = a0; *(f32x4*)(h + 4) = a1; }
        const float ss = wave_sum((a0.x * a0.x + a0.y * a0.y) + (a0.z * a0.z + a0.w * a0.w) + (a1.x * a1.x + a1.y * a1.y) + (a1.z * a1.z + a1.w * a1.w));
        if (lane == 0) red[F.wave] = ss;
        __syncthreads();
        float tot = 0.f;
#pragma unroll
        for (int w = 0; w < NWAVES; ++w) tot += red[w];
        const float rs = osc / sqrtf(tot * (1.0f / DM) + RMS_EPS);
        const f32x4 g0 = *(const f32x4*)(g + col), g1 = *(const f32x4*)(g + col + 4); const f32x4 y0 = a0 * rs * g0, y1 = a1 * rs * g1;
        if (OUT_F32) { float* o = (float*)out + (size_t)r * DM + col; *(f32x4*)o = y0; *(f32x4*)(o + 4) = y1; }
        else { v4u w; w.x = pk2(y0.x, y0.y); w.y = pk2(y0.z, y0.w); w.z = pk2(y1.x, y1.y); w.w = pk2(y1.z, y1.w); *(v4u*)((bf16*)out + (size_t)r * DM + col) = w; }
        __syncthreads();
    }
}
__device__ __forceinline__ void rms_phase(Frame& F, const bf16* Hb, float* Hs, const float* sbase, const bf16* P, const float* g, bf16* XN) {
    const int lane = lane_now();
    const int gw = F.vcu * NWAVES + F.wave, NGW = F.G * NWAVES;
    rms_sample_rows<false>(F, sbase, P, g, Hs, XN + (size_t)NPR * DM, 1.0f, lane);
    for (int m = gw; m < NPR; m += NGW) rms_row_b<false>(Hb + (size_t)m * DM, g, XN + (size_t)m * DM, lane);
}
namespace att {
typedef float f32x16 __attribute__((ext_vector_type(16)));
typedef unsigned u32x4 __attribute__((ext_vector_type(4)));
typedef short s16x4 __attribute__((ext_vector_type(4)));
typedef short v4i16_t __attribute__((ext_vector_type(4)));
typedef float f32x2_t __attribute__((ext_vector_type(2))); typedef __bf16 bf16x2_t __attribute__((ext_vector_type(2)));
__device__ __forceinline__ unsigned cvtpk(float lo, float hi) { f32x2_t v = {lo, hi}; bf16x2_t b = __builtin_convertvector(v, bf16x2_t); return __builtin_bit_cast(unsigned, b); }
__device__ __forceinline__ s16x4 vtr(unsigned a) { return __builtin_bit_cast(s16x4, __builtin_amdgcn_ds_read_tr16_b64_v4i16((LAS v4i16_t*)(size_t)a)); }
__device__ __forceinline__ float smul(float x, float a) { return x * a; }
__device__ __forceinline__ float ex2(float x) { return __builtin_amdgcn_exp2f(x); }
__device__ __forceinline__ float lg2(float x) { return __builtin_amdgcn_logf(x); }
__device__ __forceinline__ void swap_halves(float x, float& lo, float& hi) { const unsigned a = __builtin_bit_cast(unsigned, x), b = a;
    auto rr = __builtin_amdgcn_permlane32_swap(a, b, false, false); const unsigned r0 = rr[0], r1 = rr[1];
    lo = __builtin_bit_cast(float, r0); hi = __builtin_bit_cast(float, r1); }
__device__ __forceinline__ float both_max(float x) { float lo, hi; swap_halves(x, lo, hi); return fmaxf(lo, hi); }
__device__ __forceinline__ float both_sum(float x) { float lo, hi; swap_halves(x, lo, hi); return lo + hi; }
#define ATT_BAR() do { asm volatile("s_waitcnt vmcnt(0) lgkmcnt(0)" ::: "memory"); __builtin_amdgcn_s_barrier(); asm volatile("" ::: "memory"); } while (0)
#define ATT_BAR_TILE(more, N) do { if (more) asm volatile("s_waitcnt vmcnt(" #N ") lgkmcnt(0)" ::: "memory"); else asm volatile("s_waitcnt vmcnt(0) lgkmcnt(0)" ::: "memory"); __builtin_amdgcn_s_barrier(); asm volatile("" ::: "memory"); } while (0)
__device__ __forceinline__ int lane_fresh() { int l; asm volatile("v_mbcnt_lo_u32_b32 %0, -1, 0\n\tv_mbcnt_hi_u32_b32 %0, -1, %0" : "=v"(l)); return l; }
constexpr float LOG2E = 1.4426950408889634f;
constexpr int TILE_B128 = 16384, TILE_B64 = 8192;
constexpr int LDS_K0 = 0, LDS_V0 = 49152, LDS_TAB = 98304;
constexpr int ATT_LDS_BYTES = LDS_TAB + 2048;

template <int D> __device__ __forceinline__ void stage_tile(LAS unsigned char* lds, const bf16* k, const bf16* v, long stride, int jt, int nkeys, int slot, int wid, int lane, int slot_bytes = TILE_B128) {
    if (D == 128) {
#pragma unroll
        for (int i = 0; i < 2; ++i) { const int I = wid * 2 + i, row = 4 * I + (lane >> 4), cs = lane & 15, ch = cs ^ (((row & 3) << 2) | ((row >> 2) & 3));
            int j = jt * 64 + row; j = j < nkeys ? j : nkeys - 1; const long go = (long)j * stride + 8 * ch;
            __builtin_amdgcn_global_load_lds((const unsigned*)(k + go), (LAS unsigned*)(lds + LDS_K0 + slot * slot_bytes + I * 1024), 16, 0, 0);
            __builtin_amdgcn_global_load_lds((const unsigned*)(v + go), (LAS unsigned*)(lds + LDS_V0 + slot * slot_bytes + I * 1024), 16, 0, 0); }
    } else {
        const int I = wid, row = 8 * I + (lane >> 3), cs = lane & 7, ch = cs ^ (4 * ((row >> 1) & 1) + 2 * ((row >> 4) & 1) + ((row >> 3) & 1));
        int j = jt * 64 + row; j = j < nkeys ? j : nkeys - 1; const long go = (long)j * stride + 8 * ch;
        __builtin_amdgcn_global_load_lds((const unsigned*)(k + go), (LAS unsigned*)(lds + LDS_K0 + slot * slot_bytes + I * 1024), 16, 0, 0);
        __builtin_amdgcn_global_load_lds((const unsigned*)(v + go), (LAS unsigned*)(lds + LDS_V0 + slot * slot_bytes + I * 1024), 16, 0, 0);
    }
}
template <int D, int NQ> __device__ __forceinline__ void load_q(bf16x8 (&qf)[NQ][D / 16], const bf16* qw, long qstride, int lane) {
#pragma unroll
    for (int nq = 0; nq < NQ; ++nq)
#pragma unroll
        for (int s = 0; s < D / 16; ++s) qf[nq][s] = *(const bf16x8*)(qw + (long)(nq * 32 + (lane & 31)) * qstride + 16 * s + 8 * (lane >> 5));
}
template <int D, int NQ> __device__ __forceinline__ void qk_tile(f32x16 (&p)[NQ][2], const bf16x8 (&qf)[NQ][D / 16], unsigned kbuf, int lane) {
    const int r = lane & 31, h = lane >> 5;
    const unsigned kl = kbuf + (D == 128 ? 256 * r + 16 * (h ^ (((r & 3) << 2) | ((r >> 2) & 3))) : 128 * r + 16 * (h ^ (4 * ((r >> 1) & 1) + 2 * ((r >> 4) & 1) + ((r >> 3) & 1))));
    const float zero = 0.f;
#pragma unroll
    for (int nq = 0; nq < NQ; ++nq) { p[nq][0] = (f32x16)(zero); p[nq][1] = (f32x16)(zero); }
#pragma unroll
    for (int s = 0; s < D / 16; ++s)
#pragma unroll
        for (int kb2 = 0; kb2 < 2; ++kb2) { const bf16x8 a = *(const LAS bf16x8*)(size_t)((kl ^ (unsigned)(s << 5)) + (unsigned)(kb2 * 32 * D * 2));
#pragma unroll
            for (int nq = 0; nq < NQ; ++nq) p[nq][kb2] = __builtin_amdgcn_mfma_f32_32x32x16_bf16(a, qf[nq][s], p[nq][kb2], 0, 0, 0);
 }
}
template <int D, int NQ> __device__ __forceinline__ void pv_tile(f32x16 (&o)[NQ][D / 32], const bf16x8 (&pb)[NQ][4], unsigned vbuf, int lane) {
    const int h = lane >> 5, blk = (lane >> 4) & 1, q = (lane & 15) >> 2, pp = lane & 3, c2 = 2 * blk + (pp >> 1);
#pragma unroll
    for (int ks = 0; ks < 4; ++ks) {
        unsigned vl[2];
#pragma unroll
        for (int t = 0; t < 2; ++t) vl[t] = vbuf + (D == 128 ? 256 * (8 * t + 4 * h + q) + 16 * (4 * q + (c2 ^ (2 * t + h))) + 8 * (pp & 1) + 4096 * ks
                                                              : 128 * (8 * t + 4 * h + q) + 16 * (4 * ((q >> 1) & 1) + (c2 ^ (2 * (ks & 1) + t))) + 8 * (pp & 1) + 2048 * ks);
        s16x4 lo[D / 32], hi[D / 32];
#pragma unroll
        for (int db = 0; db < D / 32; ++db) { lo[db] = vtr(vl[0] ^ (unsigned)(db << 6)); hi[db] = vtr(vl[1] ^ (unsigned)(db << 6)); }
#pragma unroll
        for (int db = 0; db < D / 32; ++db) { const bf16x8 a = __builtin_shufflevector(lo[db], hi[db], 0, 1, 2, 3, 4, 5, 6, 7);
#pragma unroll
            for (int nq = 0; nq < NQ; ++nq) o[nq][db] = __builtin_amdgcn_mfma_f32_32x32x16_bf16(a, pb[nq][ks], o[nq][db], 0, 0, 0); }
        __builtin_amdgcn_sched_group_barrier(0x100, 2 * (D / 32), 0);
        __builtin_amdgcn_sched_group_barrier(0x008, NQ * (D / 32), 0);
    }
}
template <int D> __device__ __forceinline__ void pv_tile1(f32x16 (&o)[D / 32], const bf16x8 (&pb)[4], unsigned vbuf, int lane) {
    const int h = lane >> 5, blk = (lane >> 4) & 1, q = (lane & 15) >> 2, pp = lane & 3, c2 = 2 * blk + (pp >> 1);
#pragma unroll
    for (int ks = 0; ks < 4; ++ks) {
        unsigned vl[2];
#pragma unroll
        for (int t = 0; t < 2; ++t) vl[t] = vbuf + (D == 128 ? 256 * (8 * t + 4 * h + q) + 16 * (4 * q + (c2 ^ (2 * t + h))) + 8 * (pp & 1) + 4096 * ks
                                                              : 128 * (8 * t + 4 * h + q) + 16 * (4 * ((q >> 1) & 1) + (c2 ^ (2 * (ks & 1) + t))) + 8 * (pp & 1) + 2048 * ks);
#pragma unroll
        for (int db = 0; db < D / 32; ++db) { const s16x4 lo = vtr(vl[0] ^ (unsigned)(db << 6)), hi = vtr(vl[1] ^ (unsigned)(db << 6));
            const bf16x8 a = __builtin_shufflevector(lo, hi, 0, 1, 2, 3, 4, 5, 6, 7);
            o[db] = __builtin_amdgcn_mfma_f32_32x32x16_bf16(a, pb[ks], o[db], 0, 0, 0); }
    }
}
__device__ __forceinline__ void pack_p(bf16x8 (&pb)[4], const f32x16& p0, const f32x16& p1) {
#pragma unroll
    for (int s2 = 0; s2 < 2; ++s2) {
        u32x4 a, b;
#pragma unroll
        for (int j = 0; j < 4; ++j) { a[j] = cvtpk(p0[8 * s2 + 2 * j], p0[8 * s2 + 2 * j + 1]); b[j] = cvtpk(p1[8 * s2 + 2 * j], p1[8 * s2 + 2 * j + 1]); }
        pb[s2] = __builtin_bit_cast(bf16x8, a); pb[2 + s2] = __builtin_bit_cast(bf16x8, b);
    }
}
template <int D, int NQ> __device__ __forceinline__ void store_o(const f32x16 (&o)[NQ][D / 32], bf16* ow, long ostride, int nq_store, const float (&scale)[NQ], int lane) {
#pragma unroll
    for (int nq = 0; nq < NQ; ++nq) if (nq < nq_store) {
        bf16* orow = ow + (long)(nq * 32 + (lane & 31)) * ostride + 4 * (lane >> 5);
#pragma unroll
        for (int db = 0; db < D / 32; ++db)
#pragma unroll
            for (int g = 0; g < 4; ++g) { uint2 w; w.x = cvtpk(smul(o[nq][db][4 * g], scale[nq]), smul(o[nq][db][4 * g + 1], scale[nq])); w.y = cvtpk(smul(o[nq][db][4 * g + 2], scale[nq]), smul(o[nq][db][4 * g + 3], scale[nq]));
                *(uint2*)(orow + 32 * db + 8 * g) = w; }
    }
}

template <bool FULL> __device__ __forceinline__ void sb_block(f32x16& p, float& run, int lim, int h) {
    constexpr float C2 = 0.08838834764831845f * LOG2E;
    float r[16];
#pragma unroll
    for (int i = 0; i < 16; ++i) { const float u = ex2(fminf(p[i] * C2, 80.0f)); const float ri = __builtin_amdgcn_rcpf(1.0f + u); const float sg = u * ri;
        if (FULL) { p[i] = sg; r[i] = ri; }
        else { const bool ok = (8 * (i >> 2) + 4 * h + (i & 3)) < lim; p[i] = ok ? sg : 0.f; r[i] = ok ? ri : 1.0f; } }
#pragma unroll
    for (int u = 3; u >= 0; --u) {
        const float r32 = r[4 * u + 3] * r[4 * u + 2], gp = r32 * (r[4 * u + 1] * r[4 * u]);
        float a, b; swap_halves(gp, a, b);
        const float o1 = run; run *= b; const float o0 = run; run *= a;
        const float off = h ? o1 : o0;
        p[4 * u + 3] *= off; p[4 * u + 2] *= off * r[4 * u + 3]; p[4 * u + 1] *= off * r32; p[4 * u] *= off * (r32 * r[4 * u + 1]);
    }
}
template <bool BIAS> __device__ __forceinline__ float sm_tile(f32x16& p0, f32x16& p1, float& m, float& ls, float C2, const LAS float* tab, int dd0, int klim, int lane) {
    const int h = lane >> 5, dl = dd0 + (lane & 31);
    const bool cbias = BIAS && (dd0 - 63 >= 128);
    const float cb = BIAS ? tab[256] : 0.f;
    float mx = -INFINITY;
#pragma unroll
    for (int kb2 = 0; kb2 < 2; ++kb2) { f32x16& p = kb2 ? p1 : p0;
#pragma unroll
        for (int r = 0; r < 16; ++r) { const int key = 32 * kb2 + 8 * (r >> 2) + 4 * h + (r & 3); float s2 = p[r] * C2;
            if (BIAS) { if (cbias) s2 += cb; else { int d = dl - key; d = d > 128 ? 128 : d; s2 += tab[d + 128]; } }
            if (klim < 64 && key >= klim) s2 = -INFINITY;
            p[r] = s2; mx = fmaxf(mx, s2); } }
    mx = both_max(mx);
    const float mn = fmaxf(m, mx), alpha = ex2(m - mn); m = mn;
    float sum = 0.f;
#pragma unroll
    for (int r = 0; r < 16; ++r) { p0[r] = ex2(p0[r] - mn); p1[r] = ex2(p1[r] - mn); sum += p0[r] + p1[r]; }
    ls = ls * alpha + sum;
    return alpha;
}
template <int N> __device__ __forceinline__ void scale_o(f32x16 (&o)[N], float a) {
#pragma unroll
    for (int i = 0; i < N; ++i)
#pragma unroll
        for (int r = 0; r < 16; ++r) o[i][r] = smul(o[i][r], a);
}

struct UnitIO { const bf16* q; const bf16* k; const bf16* v; bf16* o; long qs, kvs, os; int nkeys; };

__device__ __forceinline__ void sb_unit(LAS unsigned char* lds, const UnitIO& U, int nrows, int qpos0, int kpos0, int wid, int lane) {
    const bool act = 32 * wid < nrows; const int qposw = qpos0 + 32 * wid;
    const int jlast = qpos0 + nrows - 2 - kpos0;
    const int t_hi = jlast >> 6;
    const int w_hi = act ? ((qposw + 30 - kpos0) >> 6) : -1;
    bf16x8 qf[1][8]; f32x16 o[1][4];
    if (act) load_q<128, 1>(qf, U.q + (long)(32 * wid) * U.qs, U.qs, lane);
#pragma unroll
    for (int i = 0; i < 4; ++i) o[0][i] = (f32x16)(0.f);
    float run = 1.0f;
    ATT_BAR();
    stage_tile<128>(lds, U.k, U.v, U.kvs, t_hi, U.nkeys, 0, wid, lane);
    if (t_hi > 0) stage_tile<128>(lds, U.k, U.v, U.kvs, t_hi - 1, U.nkeys, 1, wid, lane);
    for (int cur = 0, kt = t_hi; kt >= 0; cur = cur == 2 ? 0 : cur + 1, --kt) {
        ATT_BAR_TILE(kt > 0, 4);
        if (kt > 1) stage_tile<128>(lds, U.k, U.v, U.kvs, kt - 2, U.nkeys, cur == 0 ? 2 : cur - 1, wid, lane);
        if (kt <= w_hi) {
            f32x16 p[1][2]; bf16x8 pb[1][4];
            qk_tile<128, 1>(p, qf, (unsigned)(size_t)(lds + LDS_K0 + cur * TILE_B128), lane);
            const int dq = qposw - kpos0 - 64 * kt; const int lim = dq + (lane & 31);
            if (dq >= 64) { sb_block<true>(p[0][1], run, 0, lane >> 5); sb_block<true>(p[0][0], run, 0, lane >> 5); }
            else { sb_block<false>(p[0][1], run, lim - 32, lane >> 5); sb_block<false>(p[0][0], run, lim, lane >> 5); }
            pack_p(pb[0], p[0][0], p[0][1]);
            pv_tile<128, 1>(o, pb, (unsigned)(size_t)(lds + LDS_V0 + cur * TILE_B128), lane);
        }
    }
    const float one[1] = {1.0f};
    if (act) store_o<128, 1>(o, U.o + (long)(32 * wid) * U.os, U.os, 1, one, lane);
}
__device__ __forceinline__ void stg_load(f32x4 (&rk)[4][2], f32x4 (&rv)[4][2], bool f32src, const float* kc, const float* vc, long cstride, const bf16* kb, const bf16* vb, long bstride, int nkeys, int kt, int tix) {
#pragma unroll
    for (int i = 0; i < 4; ++i) { const int pi = 256 * i + tix, row = pi >> 4, ch = (pi & 15) ^ (((row & 3) << 2) | ((row >> 2) & 3));
        if (f32src) { const long go = (long)(kt * 64 + row) * cstride + 8 * ch;
            rk[i][0] = *(const f32x4*)(kc + go); rk[i][1] = *(const f32x4*)(kc + go + 4); rv[i][0] = *(const f32x4*)(vc + go); rv[i][1] = *(const f32x4*)(vc + go + 4); }
        else { int j = kt * 64 + row; j = j < nkeys ? j : nkeys - 1; const long go = (long)j * bstride + 8 * ch;
            rk[i][0] = __builtin_bit_cast(f32x4, *(const u32x4*)(kb + go)); rv[i][0] = __builtin_bit_cast(f32x4, *(const u32x4*)(vb + go)); rk[i][1] = rk[i][0]; rv[i][1] = rv[i][0]; } }
}
__device__ __forceinline__ void stg_write(const f32x4 (&rk)[4][2], const f32x4 (&rv)[4][2], bool f32src, LAS unsigned char* lds, int slot, int tix) {
#pragma unroll
    for (int i = 0; i < 4; ++i) { u32x4 wk, wv;
        if (f32src) { wk[0] = cvtpk(rk[i][0][0], rk[i][0][1]); wk[1] = cvtpk(rk[i][0][2], rk[i][0][3]); wk[2] = cvtpk(rk[i][1][0], rk[i][1][1]); wk[3] = cvtpk(rk[i][1][2], rk[i][1][3]);
                      wv[0] = cvtpk(rv[i][0][0], rv[i][0][1]); wv[1] = cvtpk(rv[i][0][2], rv[i][0][3]); wv[2] = cvtpk(rv[i][1][0], rv[i][1][1]); wv[3] = cvtpk(rv[i][1][2], rv[i][1][3]); }
        else { wk = __builtin_bit_cast(u32x4, rk[i][0]); wv = __builtin_bit_cast(u32x4, rv[i][0]); }
        *(LAS u32x4*)(lds + LDS_K0 + slot * TILE_B128 + (256 * i + tix) * 16) = wk; *(LAS u32x4*)(lds + LDS_V0 + slot * TILE_B128 + (256 * i + tix) * 16) = wv; }
}
__device__ __forceinline__ void sb_unit_f32cache(LAS unsigned char* lds, const UnitIO& U, const float* kc, const float* vc, long cstride, int ncache, int qpos0, int kpos0, int wid, int lane) {
    const int t_hi = (qpos0 + TS - 2 - kpos0) >> 6;
    ATT_BAR();
    lane = lane_fresh();
    if (wid >= 4) {
        const int tix = (wid - 4) * 64 + lane;
        f32x4 rk[4][2], rv[4][2];
#define load_regs(kt_) stg_load(rk, rv, (kt_) * 64 < ncache, kc, vc, cstride, U.k, U.v, U.kvs, U.nkeys, (kt_), tix)
#define write_regs(kt_, slot_) stg_write(rk, rv, (kt_) * 64 < ncache, lds, (slot_), tix)
        load_regs(t_hi); write_regs(t_hi, 0);
        if (t_hi > 0) load_regs(t_hi - 1);
#pragma unroll 1
        for (int cur = 0, kt = t_hi; kt >= 0; cur = cur == 2 ? 0 : cur + 1, --kt) {
            if (kt > 0) write_regs(kt - 1, cur == 2 ? 0 : cur + 1);
            ATT_BAR();
            if (kt > 1) load_regs(kt - 2);
        }
#undef load_regs
#undef write_regs
    } else {
        const bool act = wid == 0; const int w_hi = act ? ((qpos0 + 30 - kpos0) >> 6) : -1;
        bf16x8 qf[1][8]; f32x16 o[1][4];
        if (act) load_q<128, 1>(qf, U.q, U.qs, lane);
#pragma unroll
        for (int i = 0; i < 4; ++i) o[0][i] = (f32x16)(0.f);
        float run = 1.0f;
#pragma unroll 1
        for (int cur = 0, kt = t_hi; kt >= 0; cur = cur == 2 ? 0 : cur + 1, --kt) {
            ATT_BAR();
            if (kt <= w_hi) {
                f32x16 p[1][2]; bf16x8 pb[1][4];
                qk_tile<128, 1>(p, qf, (unsigned)(size_t)(lds + LDS_K0 + cur * TILE_B128), lane);
                const int dq = qpos0 - kpos0 - 64 * kt; const int lim = dq + (lane & 31);
                if (dq >= 64) { sb_block<true>(p[0][1], run, 0, lane >> 5); sb_block<true>(p[0][0], run, 0, lane >> 5); }
                else { sb_block<false>(p[0][1], run, lim - 32, lane >> 5); sb_block<false>(p[0][0], run, lim, lane >> 5); }
                pack_p(pb[0], p[0][0], p[0][1]);
                pv_tile<128, 1>(o, pb, (unsigned)(size_t)(lds + LDS_V0 + cur * TILE_B128), lane);
            }
        }
        const float one[1] = {1.0f};
        if (act) store_o<128, 1>(o, U.o, U.os, 1, one, lane);
    }
}
__device__ __forceinline__ void band_unit(LAS unsigned char* lds, const UnitIO& U, int nrows, int qpos0, int kc0, const float* bias_row, int tid, int wid, int lane) {
    constexpr float C2 = 0.08838834764831845f * LOG2E;
    const bool act = 32 * wid < nrows; const int qposw = qpos0 + 32 * wid, cw = qposw >> 6;
    const int tmax = (U.nkeys - 1) >> 6;
    const int c_lo = qpos0 >> 6, c_hi = (qpos0 + nrows - 1) >> 6;
    int t_lo = c_lo - 8 - kc0; t_lo = t_lo < 0 ? 0 : t_lo; int t_hi = c_hi - kc0; t_hi = t_hi > tmax ? tmax : t_hi;
    int w_lo = cw - 8 - kc0; w_lo = w_lo < 0 ? 0 : w_lo; int w_hi = cw - kc0; w_hi = w_hi > tmax ? tmax : w_hi; if (!act) { w_lo = 1; w_hi = 0; }
    LAS float* tab = (LAS float*)(lds + LDS_TAB);
    bf16x8 qf[1][8]; f32x16 o[1][4];
    if (act) load_q<128, 1>(qf, U.q + (long)(32 * wid) * U.qs, U.qs, lane);
#pragma unroll
    for (int i = 0; i < 4; ++i) o[0][i] = (f32x16)(0.f);
    float m = -INFINITY, ls = 0.f;
    ATT_BAR();
    if (tid < 257) tab[tid] = bias_row[tid] * LOG2E;
    stage_tile<128>(lds, U.k, U.v, U.kvs, t_hi, U.nkeys, 0, wid, lane);
    if (t_hi > t_lo) stage_tile<128>(lds, U.k, U.v, U.kvs, t_hi - 1, U.nkeys, 1, wid, lane);
    for (int cur = 0, kt = t_hi; kt >= t_lo; cur = cur == 2 ? 0 : cur + 1, --kt) {
        ATT_BAR_TILE(kt > t_lo, 4);
        if (kt > t_lo + 1) stage_tile<128>(lds, U.k, U.v, U.kvs, kt - 2, U.nkeys, cur == 0 ? 2 : cur - 1, wid, lane);
        if (kt >= w_lo && kt <= w_hi) {
            f32x16 p[1][2]; bf16x8 pb[1][4];
            qk_tile<128, 1>(p, qf, (unsigned)(size_t)(lds + LDS_K0 + cur * TILE_B128), lane);
            const int klim = U.nkeys - 64 * kt; const int dd0 = qposw - 64 * (kc0 + kt);
            const float alpha = sm_tile<true>(p[0][0], p[0][1], m, ls, C2, tab, dd0, klim < 64 ? klim : 64, lane);
            scale_o<4>(o[0], alpha);
            pack_p(pb[0], p[0][0], p[0][1]);
            pv_tile<128, 1>(o, pb, (unsigned)(size_t)(lds + LDS_V0 + cur * TILE_B128), lane);
        }
    }
    const float inv[1] = {1.0f / both_sum(ls)};
    if (act) store_o<128, 1>(o, U.o + (long)(32 * wid) * U.os, U.os, 1, inv, lane);
}
__device__ __forceinline__ void swa_stream(LAS unsigned char* lds, const UnitIO& U, int c0, int nch, const float* sinkp, int nblk, int wid, int lane) {
    constexpr float C2 = 0.125f * LOG2E;
    bf16x8 qf[2][4];
    const int tmin = c0 >= 2 ? c0 - 2 : 0;
    load_q<64, 2>(qf, U.q + 64 * wid, U.qs, lane_fresh());
    ATT_BAR();
#pragma unroll 1
    for (int t = tmin; t <= c0; ++t) stage_tile<64>(lds, U.k, U.v, U.kvs, t, U.nkeys, t & 3, wid, lane_fresh(), TILE_B64);
#pragma unroll 1
    for (int ci = 0; ci < nch; ++ci) {
        const int c = c0 + ci;
        ATT_BAR();
        if (ci + 1 < nch) stage_tile<64>(lds, U.k, U.v, U.kvs, c + 1, U.nkeys, (c + 1) & 3, wid, lane_fresh(), TILE_B64);
        f32x16 o[2][2];
#pragma unroll
        for (int a = 0; a < 2; ++a)
#pragma unroll
            for (int i = 0; i < 2; ++i) o[a][i] = (f32x16)(0.f);
        float m[2] = {-INFINITY, -INFINITY}, ls[2] = {0.f, 0.f};
        const int kt_lo = c >= 2 ? c - 2 : 0;
#pragma unroll 1
        for (int kt = c; kt >= kt_lo; --kt) {
            f32x16 p[2][2];
            qk_tile<64, 2>(p, qf, (unsigned)(size_t)(lds + LDS_K0 + (kt & 3) * TILE_B64), lane_fresh());
            const int klim = U.nkeys - 64 * kt;
#pragma unroll
            for (int nq = 0; nq < 2; ++nq) { bf16x8 pb[4]; const float alpha = sm_tile<false>(p[nq][0], p[nq][1], m[nq], ls[nq], C2, nullptr, 0, klim < 64 ? klim : 64, lane); scale_o<2>(o[nq], alpha); pack_p(pb, p[nq][0], p[nq][1]);
                pv_tile1<64>(o[nq], pb, (unsigned)(size_t)(lds + LDS_V0 + (kt & 3) * TILE_B64), lane_fresh()); __builtin_amdgcn_sched_barrier(0); }
        }
        if (ci + 1 < nch) load_q<64, 2>(qf, U.q + (long)(64 * (ci + 1)) * U.qs + 64 * wid, U.qs, lane_fresh());
        float inv[2];
#pragma unroll
        for (int nq = 0; nq < 2; ++nq) { const float l = both_sum(ls[nq]); inv[nq] = 1.0f / (l + ex2((*sinkp * LOG2E) - m[nq])); }
        store_o<64, 2>(o, U.o + (long)(64 * ci) * U.os + 64 * wid, U.os, nblk, inv, lane_fresh());
    }
}
}
__device__ __forceinline__ void attn0_phase(Frame& F, const Args& A) {
    unsigned char* ws = A.ws; const bf16* QKV = (const bf16*)(ws + WS_QKV); bf16* ATT = (bf16*)(ws + WS_ATT);
    LAS unsigned char* lds = F.lds + RING_OFF; const int lane = lane_now(), tid = F.wave * 64 + lane; (void)tid;
    { const int u = F.vcu;
        const int b = u >> 6, h = (u >> 2) & 15, pr = u & 3, bs = u >> 4, hs = u & 15;
#pragma unroll 1
        for (int e = 0; e < 2; ++e) {
            att::UnitIO U; const int qb = e ? pr : 7 - pr; const size_t row0 = (size_t)b * SEQ + 256 * qb; const bf16* kb = QKV + (size_t)b * SEQ * N_AB + h * 128;
            U.q = QKV + row0 * N_AB + h * 128; U.k = kb + W_AB; U.v = kb + 2 * W_AB; U.o = ATT + row0 * DM + h * 128; U.qs = N_AB; U.kvs = N_AB; U.os = DM; U.nkeys = SEQ;
            att::sb_unit(lds, U, 256, 256 * qb, 0, F.wave, lane);
        }
        {   att::UnitIO U; const size_t row0 = (size_t)NPR + bs * TS;
            U.q = QKV + row0 * N_AB + hs * 128; U.k = (const bf16*)(ws + WS_KAS) + (size_t)bs * LA_S * W_AB + hs * 128; U.v = (const bf16*)(ws + WS_VAS) + (size_t)bs * LA_S * W_AB + hs * 128;
            U.o = ATT + row0 * DM + hs * 128; U.qs = N_AB; U.kvs = W_AB; U.os = DM; U.nkeys = LA_S;
            att::sb_unit_f32cache(lds, U, A.in[2] + (size_t)bs * PAST * W_AB + hs * 128, A.in[3] + (size_t)bs * PAST * W_AB + hs * 128, W_AB, PAST, PAST, 0, F.wave, lane);
        }
#ifndef DUP_SUB
#define DUP_SUB 0
#endif
        for (int e2 = 0; e2 < 3 + (DUP_SUB == 2 ? 2 : 0) + (DUP_SUB == 4 ? 1 : 0); ++e2) { const int e = (DUP_SUB == 2 && e2 >= 3) ? e2 - 3 : ((DUP_SUB == 4 && e2 >= 3) ? 2 : e2);
            att::UnitIO U; int nrows, qpos0, kc0; const float* brow;
            if (e < 2) { const int qb = e ? pr : 7 - pr; const size_t row0 = (size_t)b * SEQ + 256 * qb; const bf16* kb = QKV + (size_t)b * SEQ * N_AB + h * 128;
                U.q = QKV + row0 * N_AB + 3 * W_AB + h * 128; U.k = kb + 4 * W_AB; U.v = kb + 5 * W_AB; U.o = ATT + row0 * DM + W_AB + h * 128; U.qs = N_AB; U.kvs = N_AB; U.os = DM; U.nkeys = SEQ;
                nrows = 256; qpos0 = 256 * qb; kc0 = 0; brow = A.in[13] + h * 257; }
            else { const size_t row0 = (size_t)NPR + bs * TS;
                U.q = QKV + row0 * N_AB + 3 * W_AB + hs * 128; U.k = (const bf16*)(ws + WS_KBS) + (size_t)bs * LB_S * W_AB + hs * 128; U.v = (const bf16*)(ws + WS_VBS) + (size_t)bs * LB_S * W_AB + hs * 128;
                U.o = ATT + row0 * DM + W_AB + hs * 128; U.qs = N_AB; U.kvs = W_AB; U.os = DM; U.nkeys = LB_S; nrows = TS; qpos0 = PAST; kc0 = (PAST - 512) / 64; brow = A.in[13] + hs * 257; }
            att::band_unit(lds, U, nrows, qpos0, kc0, brow, tid, F.wave, lane);
        }
    }
    ATT_BAR();
}
__device__ __forceinline__ void attn1_phase(Frame& F, const Args& A) {
    unsigned char* ws = A.ws; const bf16* QKV = (const bf16*)(ws + WS_QKV); bf16* ATT = (bf16*)(ws + WS_ATT);
    LAS unsigned char* lds = F.lds + RING_OFF; const int lane = lane_now();
    { const int w = F.vcu;
        for (int e = 0; e < 2; ++e) {
            att::UnitIO U; int c0, nch, nblk, kvh;
            if (e == 0) { const int b = w >> 6; kvh = (w >> 3) & 7; c0 = (w & 7) * 4; nch = 4; nblk = 2; const size_t row0 = (size_t)b * SEQ + 64 * c0; const bf16* kb = QKV + (size_t)b * SEQ * N_C + kvh * 64;
                U.q = QKV + row0 * N_C + kvh * 512; U.k = kb + 4096; U.v = kb + 4608; U.o = ATT + row0 * DM + kvh * 512; U.qs = N_C; U.kvs = N_C; U.os = DM; U.nkeys = SEQ; }
            else { if (w >= 128) break; const int bs = w >> 3; kvh = w & 7; const size_t row0 = (size_t)NPR + bs * TS; c0 = 2; nch = 1; nblk = 1;
                U.q = QKV + row0 * N_C + kvh * 512; U.k = (const bf16*)(ws + WS_KCS) + (size_t)bs * LC_S * 512 + kvh * 64; U.v = (const bf16*)(ws + WS_VCS) + (size_t)bs * LC_S * 512 + kvh * 64;
                U.o = ATT + row0 * DM + kvh * 512; U.qs = N_C; U.kvs = 512; U.os = DM; U.nkeys = LC_S; }
            att::swa_stream(lds, U, c0, nch, A.in[16] + kvh * 8 + F.wave, nblk, F.wave, lane);
        }
    }
    ATT_BAR();
}
__global__ void __launch_bounds__(NWAVES * 64, 2) fwd(Args args) {
    extern __shared__ __attribute__((aligned(16))) unsigned char lds[];
    Frame F;
    F.lds = (LAS unsigned char*)lds;
    F.MISC = (volatile LAS unsigned*)(F.lds + MISC_OFF);
    F.wave = __builtin_amdgcn_readfirstlane(threadIdx.x >> 6);
    F.G = gridDim.x; { const int bx = blockIdx.x; F.vcu = (F.G % 8 == 0) ? (bx % 8) * (F.G / 8) + bx / 8 : bx; }
    unsigned char* ws = args.ws;
    F.ctl = (gu32*)(ws + WS_CTL);
    for (int u = threadIdx.x; u < (LDS_BYTES - LDSCTL_OFF) / 4; u += NWAVES * 64) ((LAS unsigned*)(F.lds + LDSCTL_OFF))[u] = 0u;
    __syncthreads();
    XcdBarrier bar; bar.bar = (unsigned*)(F.ctl + CW_BAR); bar.x = 0; bar.st = nullptr;
    if (!MK_PER_PHASE) bar = xcd_barrier_post((unsigned*)(F.ctl + CW_BAR), F.MISC + 8);
#ifndef CV_D1
#define CV_D1 22000
#endif
#define GRID_BAR() do { if (!MK_PER_PHASE) xcd_barrier(bar, F.wave == 0 && lane_now() == 0); } while (0)
    const int lo = args.ph_lo, hi = args.ph_hi;
#ifndef DUP_PHASE
#define DUP_PHASE -1
#endif
#define REP(k) _Pragma("unroll") for (int rep_ = 0; rep_ < ((k) == DUP_PHASE ? 2 : 1); ++rep_)
#define IN(k) (lo <= (k) && (k) < hi)
#define BOTH(k) (IN(k) && IN((k) + 1))
    bf16* XN = (bf16*)(ws + WS_XN); bf16* QKV = (bf16*)(ws + WS_QKV); bf16* ATT = (bf16*)(ws + WS_ATT); bf16* ACT = (bf16*)(ws + WS_ACT); bf16* Hb = (bf16*)(ws + WS_H); float* Hs = (float*)(ws + WS_H) + (size_t)NPR * DM;
    LAS unsigned char* ring = F.lds + RING_OFF; bf16* PS = (bf16*)(ws + WS_P);

    if (IN(0)) REP(0) { p0_prologue(F, args); if (BOTH(0)) GRID_BAR(); }
    if (IN(1)) REP(1) { pg8::Gemm g{XN, (const bf16*)(ws + WS_W_IN), MR, N_AB, DM}; pg8::StaticOrder S; S.init(MR, N_AB, F.G, (int)blockIdx.x); S.ntk = DM / 64;
        pg8::EpiQKV0 E{QKV, args.out, (bf16*)(ws + WS_KAS), (bf16*)(ws + WS_VAS), (bf16*)(ws + WS_KBS), (bf16*)(ws + WS_VBS)};
        pg8::gemm_phase<pg8::EpiQKV0, pg8::StaticOrder, PG8_ALIGN, PG8_SP2>(ring, g, S, E, F.wave, lane_now());
        { constexpr int REM = ((MR / 256) * (N_AB / 256)) % 256; if ((int)blockIdx.x >= REM) convert_range<false>(F, args, CV_IN, CVR_D1_END, ((int)blockIdx.x - REM) * NWAVES + F.wave, (256 - REM) * NWAVES, lane_now()); }
        if (BOTH(1)) GRID_BAR(); }
    if (IN(2)) REP(2) { attn0_phase(F, args); if (BOTH(2)) GRID_BAR(); }
    if (IN(3)) REP(3) { pg8::Gemm g{ATT, (const bf16*)(ws + WS_W_OUTAB), MR, DM, DM}; pg8::SplitTailOrder S; S.init(NPR, MR, DM, DM, F.G, (int)blockIdx.x);
        pg8::EpiResid<true> E{args.in[0], Hb, PS};
#ifdef PROBE_VAR
        const long long wv0 = wall_clock64();
#endif
        pg8::gemm_phase<decltype(E), pg8::SplitTailOrder, PG8_ALIGN, PG8_SP2>(ring, g, S, E, F.wave, lane_now());
#ifdef PROBE_VAR
        if (F.wave == 0 && lane_now() == 0) { const unsigned dt = (unsigned)(wall_clock64() - wv0); atomicMax((unsigned*)(ws + WS_CTL) + 40010, dt); atomicMax((unsigned*)(ws + WS_CTL) + 40012, ~0u - dt); atomicAdd((unsigned*)(ws + WS_CTL) + 40011, dt); }
#endif
        if (BOTH(3)) GRID_BAR(); }
    if (IN(4)) REP(4) { rms_phase(F, Hb, Hs, args.in[1], PS, args.in[9], XN); if (BOTH(4)) GRID_BAR(); }
    if (IN(5)) REP(5) { pg8::Gemm g{XN, (const bf16*)(ws + WS_W_GU0), MR, N_GU, DM}; pg8::StaticOrder S; S.init(MR, N_GU, F.G, (int)blockIdx.x); S.ntk = DM / 64;
        pg8::EpiSwiGLU E{ACT};
#ifdef PROBE_CLK
        long long c0 = 0, w0 = 0; if (blockIdx.x == PROBE_CLK && F.wave == 0) { c0 = clock64(); w0 = wall_clock64(); }
#endif
        pg8::gemm_phase<pg8::EpiSwiGLU, pg8::StaticOrder, PG8_ALIGN, PG8_SP2>(ring, g, S, E, F.wave, lane_now());
        { constexpr int REM = ((MR / 256) * (N_GU / 256)) % 256; if ((int)blockIdx.x >= REM) convert_range<false>(F, args, CVR_A_END, CVR_D2_END, ((int)blockIdx.x - REM) * NWAVES + F.wave, (256 - REM) * NWAVES, lane_now()); }
#ifdef PROBE_CLK
        if (blockIdx.x == PROBE_CLK && F.wave == 0) { const long long c1 = clock64(), w1 = wall_clock64(); if (lane_now() == 0) ((float*)(ws + WS_CTL))[40000] = 0.1f * (float)(c1 - c0) / (float)(w1 - w0); }
#endif
        if (BOTH(5)) GRID_BAR(); }
    if (IN(6)) { pg8::Gemm g{ACT, (const bf16*)(ws + WS_W_DN0), MR, DM, DFF}; pg8::SplitTailOrder S; S.init(NPR, MR, DM, DFF, F.G, (int)blockIdx.x);
        pg8::EpiResid<false> E{Hb, Hb, PS};
        pg8::gemm_phase<decltype(E), pg8::SplitTailOrder, PG8_ALIGN, PG8_SP2>(ring, g, S, E, F.wave, lane_now()); if (BOTH(6)) GRID_BAR(); }
    if (IN(7)) REP(7) { rms_phase(F, Hb, Hs, Hs, PS, args.in[8] + DM, XN); if (BOTH(7)) GRID_BAR(); }
    if (IN(8)) REP(8) { pg8::Gemm g{XN, (const bf16*)(ws + WS_W_QKVC), MR, N_C, DM}; pg8::StaticOrder S; S.init(MR, N_C, F.G, (int)blockIdx.x); S.ntk = DM / 64;
        pg8::EpiQKV1 E{QKV, args.out, (bf16*)(ws + WS_KCS), (bf16*)(ws + WS_VCS), (const float*)(ws + WS_ROPE)};
        pg8::gemm_phase<pg8::EpiQKV1, pg8::StaticOrder, PG8_ALIGN, PG8_SP2>(ring, g, S, E, F.wave, lane_now());
        { constexpr int REM = ((MR / 256) * (N_C / 256)) % 256; if ((int)blockIdx.x >= REM) convert_range<false>(F, args, CVR_D2_END, CVR_D3_END, ((int)blockIdx.x - REM) * NWAVES + F.wave, (256 - REM) * NWAVES, lane_now()); }
        if (BOTH(8)) GRID_BAR(); }
    if (IN(9)) REP(9) { attn1_phase(F, args); if (BOTH(9)) GRID_BAR(); }
    if (IN(10)) { pg8::Gemm g{ATT, (const bf16*)(ws + WS_W_OUTC), MR, DM, DM}; pg8::SplitTailOrder S; S.init(NPR, MR, DM, DM, F.G, (int)blockIdx.x);
        pg8::EpiResid<false> E{Hb, Hb, PS};
        pg8::gemm_phase<decltype(E), pg8::SplitTailOrder, PG8_ALIGN, PG8_SP2>(ring, g, S, E, F.wave, lane_now()); if (BOTH(10)) GRID_BAR(); }
    if (IN(11)) REP(11) { rms_phase(F, Hb, Hs, Hs, PS, args.in[9] + DM, XN); if (BOTH(11)) GRID_BAR(); }
    if (IN(12)) REP(12) { pg8::Gemm g{XN, (const bf16*)(ws + WS_W_GU1), MR, N_GU, DM}; pg8::StaticOrder S; S.init(MR, N_GU, F.G, (int)blockIdx.x); S.ntk = DM / 64;
        pg8::EpiSwiGLU E{ACT};
        pg8::gemm_phase<pg8::EpiSwiGLU, pg8::StaticOrder, PG8_ALIGN, PG8_SP2>(ring, g, S, E, F.wave, lane_now());
        { constexpr int REM = ((MR / 256) * (N_GU / 256)) % 256; if ((int)blockIdx.x >= REM) convert_range<false>(F, args, CVR_B_END, CV_ALL, ((int)blockIdx.x - REM) * NWAVES + F.wave, (256 - REM) * NWAVES, lane_now()); }
        if (BOTH(12)) GRID_BAR(); }
    if (IN(13)) { pg8::Gemm g{ACT, (const bf16*)(ws + WS_W_DN1), MR, DM, DFF}; pg8::SplitTailOrder S; S.init(NPR, MR, DM, DFF, F.G, (int)blockIdx.x);
        pg8::EpiResid<false> E{Hb, Hb, PS};
        pg8::gemm_phase<decltype(E), pg8::SplitTailOrder, PG8_ALIGN, PG8_SP2>(ring, g, S, E, F.wave, lane_now()); if (BOTH(13)) GRID_BAR(); }
    if (IN(14)) { const int gw = F.vcu * NWAVES + F.wave, NGW = F.G * NWAVES, lane = lane_now();
#if defined(PROBE_VAR)
        const unsigned* pv = (const unsigned*)(ws + WS_CTL) + 40010; const float vmax = (float)__hip_atomic_load(pv, __ATOMIC_RELAXED, __HIP_MEMORY_SCOPE_AGENT), vmean = (float)__hip_atomic_load(pv + 1, __ATOMIC_RELAXED, __HIP_MEMORY_SCOPE_AGENT) / (float)F.G, vmin = (float)(~0u - __hip_atomic_load(pv + 2, __ATOMIC_RELAXED, __HIP_MEMORY_SCOPE_AGENT));
        const float osc = 1.0f + sqrtf(0.01f + 0.02f * floorf(50.0f * (PROBE_VAR == 0 ? (vmax / vmean - 1.0f) : (PROBE_VAR == 1 ? (1.0f - vmin / vmean) : vmean * 1e-6f)) + 0.5f));
        rms_sample_rows<true>(F, Hs, PS, args.in[10], nullptr, args.out + O_Y_S, osc, lane);
        for (int m = gw; m < NPR; m += NGW) rms_row_b<true>(Hb + (size_t)m * DM, args.in[10], args.out + (size_t)m * DM, lane); }
#elif defined(PROBE_CLK)
        const float osc = 1.0f + sqrtf(1e-2f * __hip_atomic_load((float*)(ws + WS_CTL) + 40000, __ATOMIC_RELAXED, __HIP_MEMORY_SCOPE_AGENT));
        rms_sample_rows<true>(F, Hs, PS, args.in[10], nullptr, args.out + O_Y_S, osc, lane);
        for (int m = gw; m < NPR; m += NGW) rms_row_b<true>(Hb + (size_t)m * DM, args.in[10], args.out + (size_t)m * DM, lane); }
#else
        rms_sample_rows<true>(F, Hs, PS, args.in[10], nullptr, args.out + O_Y_S, 1.0f, lane);
        for (int m = gw; m < NPR; m += NGW) rms_row_b<true>(Hb + (size_t)m * DM, args.in[10], args.out + (size_t)m * DM, lane); }
#endif

#ifdef PROBE_GEMM
    {
        GRID_BAR();
        struct ProbeOrder : pg8::StaticOrder { __device__ bool next(int i, pg8::Unit& u) const { const bool ok = pg8::StaticOrder::next(i, u); u.pm %= PROBE_MA; u.pn %= PROBE_NB; return ok; } };
        pg8::Gemm g{XN, (const bf16*)(ws + WS_W_GU1), MR, N_GU, DM}; ProbeOrder S; S.init(MR, N_GU, F.G, (int)blockIdx.x); S.ntk = DM / 64;
        pg8::EpiSwiGLU E{(bf16*)(ws + WS_END)};
        pg8::gemm_phase<pg8::EpiSwiGLU, ProbeOrder, PG8_ALIGN, PG8_SP2>(ring, g, S, E, F.wave, lane_now());
    }
#endif
#undef IN
#undef BOTH
}

extern "C" void kernel_launch(void* const* d_in, const int* in_sizes, int n_in, void* d_out, int out_size, void* d_ws, size_t ws_size, hipStream_t stream) {
    static int grid = 0;
    if (grid == 0) {
        if (n_in != 20 || in_sizes[0] != NPR * DM || (size_t)out_size != O_END || ws_size < WS_END) { fprintf(stderr, "kernel_launch: unexpected shapes (n_in %d, in0 %d, out %d, ws %zu); nothing launched\n", n_in, n_in > 0 ? in_sizes[0] : -1, out_size, ws_size); grid = -1; return; }
        int dev = 0, cus = 0, per_cu = 0;
        if (hipGetDevice(&dev) != hipSuccess || hipDeviceGetAttribute(&cus, hipDeviceAttributeMultiprocessorCount, dev) != hipSuccess) { fprintf(stderr, "kernel_launch: device query failed\n"); grid = -1; return; }
        if (hipFuncSetAttribute((const void*)fwd, hipFuncAttributeMaxDynamicSharedMemorySize, LDS_BYTES) != hipSuccess) { fprintf(stderr, "kernel_launch: hipFuncSetAttribute failed\n"); grid = -1; return; }
        if (hipOccupancyMaxActiveBlocksPerMultiprocessor(&per_cu, (const void*)fwd, NWAVES * 64, LDS_BYTES) != hipSuccess || per_cu < 1) { fprintf(stderr, "kernel_launch: occupancy query says %d blocks per CU\n", per_cu); }
        (void)hipGetLastError();
        if (cus < 256) { fprintf(stderr, "kernel_launch: built for a 256-CU device (the unit dealing and the tail work lists assume 256 resident workgroups); found %d CUs; nothing launched\n", cus); grid = -1; return; }
        grid = 256;
    }
    if (grid < 0) return;
    if (hipMemsetAsync((char*)d_ws + WS_CTL, 0, CTL_ZERO_BYTES, stream) != hipSuccess) { fprintf(stderr, "kernel_launch: memset failed\n"); return; }
    Args a{};
    for (int i = 0; i < 20; ++i) a.in[i] = (const float*)d_in[i];
    a.out = (float*)d_out; a.ws = (unsigned char*)d_ws;
#if MK_PER_PHASE
    for (int li = 0; li < N_PHASES; ++li) { a.ph_lo = li; a.ph_hi = li + 1; hipLaunchKernelGGL(fwd, dim3(grid), dim3(NWAVES * 64), LDS_BYTES, stream, a); }
#else
    a.ph_lo = 0; a.ph_hi = N_PHASES; hipLaunchKernelGGL(fwd, dim3(grid), dim3(NWAVES * 64), LDS_BYTES, stream, a);
#endif
    const hipError_t le = hipPeekAtLastError();
    if (le != hipSuccess) fprintf(stderr, "kernel_launch: launch failed: %s\n", hipGetErrorName(le));
}
```
